# Optimizing an MI355X kernel written in HIP

```python
import math
import jax, jax.numpy as jnp
from jax import lax
import numpy as np

D_MODEL = 2048
BATCH = 2
SEQ = 4096
DEPTH = 4
DEC_BATCH = 32
DEC_SEQ = 4
PAST_LEN = 16384
PAGE_SIZE = 128

HEAD_DIM = 64
N_HEADS_A = D_MODEL // 128
N_KV_A = 4
GROUP_A = N_HEADS_A // N_KV_A
WIDTH_A = N_HEADS_A * HEAD_DIM
KV_WIDTH_A = N_KV_A * HEAD_DIM
WINDOW = 128
N_BUCKETS = 32
MAX_DISTANCE = 128
N_HEADS_B = 4
DK_B = 128
DV_B = 256
WIDTH_BK = N_HEADS_B * DK_B
WIDTH_BV = N_HEADS_B * DV_B
GATE_RANK = 16
GATE_TAU = 16.0
GLA_CHUNK = 16
D_FF = 5632
CONV_W = 3
EPS = 1e-6
SPLITS = (WIDTH_A, KV_WIDTH_A, KV_WIDTH_A, WIDTH_BK, WIDTH_BK, WIDTH_BV, WIDTH_BV, GATE_RANK, D_MODEL, D_MODEL)
IN_COLS = sum(SPLITS)

kernel_name = "hybrid_swa_sink_gla_convffn_step"


def rms_norm(x, g):
    xf = x.astype(jnp.float32)
    y = xf * lax.rsqrt(jnp.mean(xf * xf, axis=-1, keepdims=True) + EPS)
    return (y * g.astype(jnp.float32)).astype(x.dtype)


def t5_bucket(d):
    d = jnp.maximum(d, 0)
    max_exact = N_BUCKETS // 2
    df = jnp.maximum(d, 1).astype(jnp.float32)
    large = max_exact + (jnp.log(df / max_exact) / math.log(MAX_DISTANCE / max_exact)
                         * (N_BUCKETS - max_exact)).astype(jnp.int32)
    large = jnp.minimum(large, N_BUCKETS - 1)
    return jnp.where(d < max_exact, d, large)


def window_bias(rel_bias, d):
    bias = jnp.transpose(rel_bias[t5_bucket(d)], (2, 0, 1))
    mask = (d >= 0) & (d < WINDOW)
    return bias, mask


def swa_core(q, k, v, bias, mask, sinks):
    B, N, C = q.shape[:3]
    S = k.shape[2]
    qg = q.reshape(B, N, C, N_KV_A, GROUP_A, HEAD_DIM)
    s = jnp.einsum('bnqkgd,bnskd->bnkgqs', qg, k).astype(jnp.float32) * (HEAD_DIM ** -0.5)
    s = s + bias.reshape(N_KV_A, GROUP_A, C, S).astype(jnp.float32)
    s = jnp.where(mask[None, :, None, None], s, -jnp.inf)
    sink = jnp.broadcast_to(sinks.reshape(N_KV_A, GROUP_A, 1, 1).astype(jnp.float32), s.shape[:-1] + (1,))
    p = jax.nn.softmax(jnp.concatenate([s, sink], axis=-1), axis=-1)[..., :-1]
    o = jnp.einsum('bnkgqs,bnskd->bnqkgd', p.astype(v.dtype), v)
    return o.reshape(B, N, C, WIDTH_A)


def swa_prompt(q, k, v, rel_bias, sinks):
    B, L = q.shape[:2]
    N = L // WINDOW
    qb = q.reshape(B, N, WINDOW, N_HEADS_A, HEAD_DIM)
    kb = k.reshape(B, N, WINDOW, N_KV_A, HEAD_DIM)
    vb = v.reshape(B, N, WINDOW, N_KV_A, HEAD_DIM)
    kband = jnp.concatenate([jnp.concatenate([jnp.zeros_like(kb[:, :1]), kb[:, :-1]], 1), kb], 2)
    vband = jnp.concatenate([jnp.concatenate([jnp.zeros_like(vb[:, :1]), vb[:, :-1]], 1), vb], 2)
    i = jnp.arange(WINDOW)[:, None]
    j = jnp.arange(2 * WINDOW)[None, :]
    bias, m = window_bias(rel_bias, i + WINDOW - j)
    first = (jnp.arange(N) == 0)[:, None, None] & (j < WINDOW)[None]
    mask = m[None] & ~first
    o = swa_core(qb, kband, vband, bias, mask, sinks)
    return o.reshape(B, L, WIDTH_A)


def swa_sample(q, k, v, win_k, win_v, rel_bias, sinks):
    B, T = q.shape[:2]
    R = win_k.shape[1]
    k_all = jnp.concatenate([win_k.astype(k.dtype), k], 1)
    v_all = jnp.concatenate([win_v.astype(v.dtype), v], 1)
    d = jnp.arange(T)[:, None] + R - jnp.arange(R + T)[None, :]
    bias, m = window_bias(rel_bias, d)
    o = swa_core(q[:, None], k_all[:, None], v_all[:, None], bias, m[None], sinks)[:, 0]
    return o, k_all[:, -R:], v_all[:, -R:]


def gla_chunked(q, k, v, g, s0):
    B, L, H = q.shape[:3]
    C = GLA_CHUNK if L % GLA_CHUNK == 0 else L
    N = L // C

    def to_chunks(t):
        return t.reshape(B, N, C, H, t.shape[-1]).transpose(1, 0, 3, 2, 4).astype(jnp.float32)

    qc, kc, vc, gc = to_chunks(q), to_chunks(k), to_chunks(v), to_chunks(g)
    b = jnp.cumsum(gc, axis=3)
    tri = jnp.arange(C)[:, None] >= jnp.arange(C)[None, :]
    decay = jnp.exp(jnp.where(tri[:, :, None], b[..., :, None, :] - b[..., None, :, :], -jnp.inf))
    a_intra = jnp.einsum('nbhid,nbhjd,nbhijd->nbhij', qc, kc, decay)
    o_intra = jnp.einsum('nbhij,nbhje->nbhie', a_intra, vc)
    b_last = b[..., -1:, :]
    q_inter = qc * jnp.exp(b)
    k_state = kc * jnp.exp(b_last - b)
    decay_last = jnp.exp(b_last[..., 0, :])

    def step(S, xs):
        qi, ks, vv, dl = xs
        o = jnp.einsum('bhid,bhde->bhie', qi, S)
        S = dl[..., None] * S + jnp.einsum('bhjd,bhje->bhde', ks, vv)
        return S, o

    s_fin, o_inter = lax.scan(step, s0.astype(jnp.float32), (q_inter, k_state, vc, decay_last))
    o = (o_intra + o_inter).transpose(1, 0, 3, 2, 4).reshape(B, L, H, v.shape[-1])
    return o.astype(v.dtype), s_fin


def block(x, win_k, win_v, s0, conv0, rel_bias,
          ln1, w_in, ln_q, ln_k, sinks, w_gk2, b_gk, ln_o, w_oa, w_ob, w_out,
          ln2, w_up, w_conv, b_conv, w_down):
    B, L, _ = x.shape
    h = rms_norm(x, ln1)
    proj = h @ w_in
    offs = np.cumsum(SPLITS)[:-1].tolist()
    qa, ka, va, qb, kb, vb, rb, gk_lr, ga, gb = jnp.split(proj, offs, axis=-1)
    qa = rms_norm(qa.reshape(B, L, N_HEADS_A, HEAD_DIM), ln_q)
    ka = rms_norm(ka.reshape(B, L, N_KV_A, HEAD_DIM), ln_k)
    va = va.reshape(B, L, N_KV_A, HEAD_DIM)
    if win_k is None:
        oa = swa_prompt(qa, ka, va, rel_bias, sinks)
        new_k, new_v = ka[:, -WINDOW:], va[:, -WINDOW:]
    else:
        oa, new_k, new_v = swa_sample(qa, ka, va, win_k, win_v, rel_bias, sinks)
    g = jax.nn.log_sigmoid((gk_lr @ w_gk2 + b_gk).astype(jnp.float32)) / GATE_TAU
    ob, s_new = gla_chunked(qb.reshape(B, L, N_HEADS_B, DK_B) * (DK_B ** -0.5),
                            kb.reshape(B, L, N_HEADS_B, DK_B),
                            vb.reshape(B, L, N_HEADS_B, DV_B),
                            g.reshape(B, L, N_HEADS_B, DK_B), s0)
    ob = rms_norm(ob, ln_o).reshape(B, L, WIDTH_BV) * jax.nn.silu(rb)
    mix = jax.nn.sigmoid(ga) * (oa @ w_oa) + jax.nn.sigmoid(gb) * (ob @ w_ob)
    x = x + mix @ w_out
    u = rms_norm(x, ln2) @ w_up
    up = jnp.concatenate([conv0.astype(u.dtype), u], 1)
    uc = sum(w_conv[i] * up[:, i:i + L] for i in range(CONV_W)) + b_conv
    val, gate = jnp.split(uc, 2, axis=-1)
    x = x + (jax.nn.gelu(gate) * val) @ w_down
    new_conv = up[:, -(CONV_W - 1):]
    return x, new_k, new_v, s_new.astype(x.dtype), new_conv


def setup_inputs(seed: int = 0) -> dict:
    key = jax.random.key(seed)
    ks = jax.random.split(key, 32)
    f = jnp.float32
    nrm = lambda k, shape, scale: jax.random.normal(k, shape, f) * scale
    gain = lambda k, shape: 1.0 + 0.01 * jax.random.normal(k, shape, f)
    return {
        "x_prompt": nrm(ks[0], (BATCH, SEQ, D_MODEL), 1.0),
        "x_sample": nrm(ks[1], (DEC_BATCH, DEC_SEQ, D_MODEL), 1.0),
        "cache_win_k": nrm(ks[2], (DEPTH, DEC_BATCH, min(WINDOW, PAST_LEN), N_KV_A, HEAD_DIM), 1.0),
        "cache_win_v": nrm(ks[3], (DEPTH, DEC_BATCH, min(WINDOW, PAST_LEN), N_KV_A, HEAD_DIM), 1.0),
        "state_gla": nrm(ks[4], (DEPTH, DEC_BATCH, N_HEADS_B, DK_B, DV_B), 2.0),
        "state_conv": nrm(ks[5], (DEPTH, DEC_BATCH, CONV_W - 1, 2 * D_FF), 1.0),
        "rel_bias": nrm(ks[6], (N_BUCKETS, N_HEADS_A), 0.5),
        "ln1": gain(ks[7], (DEPTH, D_MODEL)),
        "w_in": nrm(ks[8], (DEPTH, D_MODEL, IN_COLS), D_MODEL ** -0.5),
        "ln_q": gain(ks[9], (DEPTH, HEAD_DIM)),
        "ln_k": gain(ks[10], (DEPTH, HEAD_DIM)),
        "sinks": nrm(ks[11], (DEPTH, N_HEADS_A), 0.5),
        "w_gk2": nrm(ks[12], (DEPTH, GATE_RANK, WIDTH_BK), GATE_RANK ** -0.5),
        "b_gk": nrm(ks[13], (DEPTH, WIDTH_BK), 0.01),
        "ln_o": gain(ks[14], (DEPTH, DV_B)),
        "w_oa": nrm(ks[15], (DEPTH, WIDTH_A, D_MODEL), WIDTH_A ** -0.5),
        "w_ob": nrm(ks[16], (DEPTH, WIDTH_BV, D_MODEL), WIDTH_BV ** -0.5),
        "w_out": nrm(ks[17], (DEPTH, D_MODEL, D_MODEL), D_MODEL ** -0.5),
        "ln2": gain(ks[18], (DEPTH, D_MODEL)),
        "w_up": nrm(ks[19], (DEPTH, D_MODEL, 2 * D_FF), D_MODEL ** -0.5),
        "w_conv": nrm(ks[20], (DEPTH, CONV_W, 2 * D_FF), CONV_W ** -0.5),
        "b_conv": nrm(ks[21], (DEPTH, 2 * D_FF), 0.01),
        "w_down": nrm(ks[22], (DEPTH, D_FF, D_MODEL), D_FF ** -0.5),
    }


def reference(x_prompt, x_sample, cache_win_k, cache_win_v, state_gla, state_conv, rel_bias,
              ln1, w_in, ln_q, ln_k, sinks, w_gk2, b_gk, ln_o, w_oa, w_ob, w_out,
              ln2, w_up, w_conv, b_conv, w_down):
    xp, xs = x_prompt, x_sample
    Bp = x_prompt.shape[0]
    kp, vp, gp, cp = [], [], [], []
    ksm, vsm, gsm, csm = [], [], [], []
    for l in range(DEPTH):
        lw = (ln1[l], w_in[l], ln_q[l], ln_k[l], sinks[l], w_gk2[l], b_gk[l], ln_o[l],
              w_oa[l], w_ob[l], w_out[l], ln2[l], w_up[l], w_conv[l], b_conv[l], w_down[l])
        s0_p = jnp.zeros((Bp, N_HEADS_B, DK_B, DV_B), jnp.float32)
        c0_p = jnp.zeros((Bp, CONV_W - 1, 2 * D_FF), xp.dtype)
        xp, nk, nv, ng, nc = block(xp, None, None, s0_p, c0_p, rel_bias, *lw)
        kp.append(nk); vp.append(nv); gp.append(ng); cp.append(nc)
        xs, nk, nv, ng, nc = block(xs, cache_win_k[l], cache_win_v[l], state_gla[l], state_conv[l], rel_bias, *lw)
        ksm.append(nk); vsm.append(nv); gsm.append(ng); csm.append(nc)
    return (xp, xs,
            jnp.stack(kp), jnp.stack(vp), jnp.stack(gp), jnp.stack(cp),
            jnp.stack(ksm), jnp.stack(vsm), jnp.stack(gsm), jnp.stack(csm))
```

```cpp
#include <hip/hip_runtime.h>
#include <cstdio>
#include <cstdint>
__device__ __forceinline__ int ltid() { int t = threadIdx.x; asm volatile("" : "+v"(t)); return t; }
__device__ __forceinline__ int lbid() { int t = blockIdx.x; asm volatile("" : "+s"(t)); return t; }
template <int CTRL> __device__ __forceinline__ float dppf(float v) { return __builtin_bit_cast(float, __builtin_amdgcn_update_dpp(0, __builtin_bit_cast(int, v), CTRL, 0xf, 0xf, true)); }
__device__ __forceinline__ float red8_sum(float v) { v += dppf<0xB1>(v); v += dppf<0x4E>(v); v += dppf<0x141>(v); return v; }
__device__ __forceinline__ float red16_sum(float v) { v = red8_sum(v); v += dppf<0x140>(v); return v; }
__device__ __forceinline__ float red16_max(float v) { v = fmaxf(v, dppf<0xB1>(v)); v = fmaxf(v, dppf<0x4E>(v)); v = fmaxf(v, dppf<0x141>(v)); v = fmaxf(v, dppf<0x140>(v)); return v; }
__device__ __forceinline__ float xrows_sum(float v) {
    const unsigned a = __builtin_bit_cast(unsigned, v);
    const auto r = __builtin_amdgcn_permlane16_swap(a, a, false, false);
    unsigned r0 = r[0], r1 = r[1]; asm volatile("" : "+v"(r0), "+v"(r1));
    v = __builtin_bit_cast(float, r0) + __builtin_bit_cast(float, r1);
    const unsigned c = __builtin_bit_cast(unsigned, v);
    const auto q = __builtin_amdgcn_permlane32_swap(c, c, false, false);
    unsigned q0 = q[0], q1 = q[1]; asm volatile("" : "+v"(q0), "+v"(q1));
    return __builtin_bit_cast(float, q0) + __builtin_bit_cast(float, q1);
}
__device__ __forceinline__ float xrows_max(float v) {
    const unsigned a = __builtin_bit_cast(unsigned, v);
    const auto r = __builtin_amdgcn_permlane16_swap(a, a, false, false);
    unsigned r0 = r[0], r1 = r[1]; asm volatile("" : "+v"(r0), "+v"(r1));
    v = fmaxf(__builtin_bit_cast(float, r0), __builtin_bit_cast(float, r1));
    const unsigned c = __builtin_bit_cast(unsigned, v);
    const auto q = __builtin_amdgcn_permlane32_swap(c, c, false, false);
    unsigned q0 = q[0], q1 = q[1]; asm volatile("" : "+v"(q0), "+v"(q1));
    return fmaxf(__builtin_bit_cast(float, q0), __builtin_bit_cast(float, q1));
}
namespace pg8 {
#define PG8_LAS __attribute__((address_space(3)))
typedef unsigned short bf16_t;
typedef short bf16x8 __attribute__((ext_vector_type(8)));
typedef float f32x4 __attribute__((ext_vector_type(4)));
typedef unsigned u32x4 __attribute__((ext_vector_type(4)));
constexpr int BM = 256, BK = 64, HALF = 128, HTB = HALF * BK * 2  , STAGE_BYTES = 8 * HTB, NXCD = 8, WGM = 8;

__host__ __device__ __forceinline__ int lds_byte(int r, int c) { const int st = (r >> 4) * 2 + (c >> 5), rr = r & 15, cc = c & 31, ob = rr * 64 + cc * 2; return st * 1024 + (ob ^ (((ob >> 9) & 1) << 5)); }
__host__ __device__ __forceinline__ void stage_rc(int b, int& R, int& C) { const int st = b / 1024, sb = b % 1024, swz = sb ^ (((sb >> 9) & 1) << 5); R = (st >> 1) * 16 + swz / 64; C = (st & 1) * 32 + (swz % 64) / 2; }
__host__ __device__ __forceinline__ int perm32x(int rho) { const int n = rho >> 4, i = rho & 15, fq = i >> 2, e = i & 3; return 16 * (fq & 1) + 8 * n + 4 * (fq >> 1) + e; }
__host__ __device__ __forceinline__ int perm32(int rho) { const int n = rho >> 4, i = rho & 15; return 8 * (i >> 2) + 4 * n + (i & 3); }

struct Unit { int pm, pn; };
struct Gemm { const bf16_t* A; const bf16_t* Bt; int M, N, K; };

struct StaticOrder {
    int nM, nN, nwg, G, c;
    __host__ __device__ void init(int M, int N, int G_, int c_) { nM = M / BM; nN = N / BM; nwg = nM * nN; G = G_; c = c_; }
    __host__ __device__ bool next(int i, Unit& u) const {
        const long L = (long)i * G + c; if (L >= nwg) return false;
        int wgid = (int)L; { const int q = nwg / NXCD, r = nwg % NXCD, xcd = wgid % NXCD, off = wgid / NXCD; wgid = (xcd < r ? xcd * (q + 1) : r * (q + 1) + (xcd - r) * q) + off; }
        const int nig = WGM * nN, gid = wgid / nig, fm = gid * WGM, gsz = (nM - fm) < WGM ? (nM - fm) : WGM;
        u.pm = fm + ((wgid % nig) % gsz); u.pn = (wgid % nig) / gsz; return true;
    }
    __device__ __forceinline__ void a_ready(const Unit&) const {}
    __device__ __forceinline__ void done(const Unit&) const {}
};

__device__ __forceinline__ unsigned cvt_pk_bf16(float lo, float hi) { unsigned r; asm volatile("v_cvt_pk_bf16_f32 %0, %1, %2" : "=v"(r) : "v"(lo), "v"(hi)); return r; }
typedef float f32x2 __attribute__((ext_vector_type(2)));
typedef __bf16 bf16x2v __attribute__((ext_vector_type(2)));
__device__ __forceinline__ unsigned cvt_pk_bf16_b(float lo, float hi) { const f32x2 v = {lo, hi}; return __builtin_bit_cast(unsigned, __builtin_convertvector(v, bf16x2v)); }

typedef unsigned u32x2 __attribute__((ext_vector_type(2)));
__device__ __forceinline__ float bfl(unsigned w) { return __uint_as_float(w << 16); }
__device__ __forceinline__ float bfh(unsigned w) { return __uint_as_float(w & 0xffff0000u); }
__device__ __forceinline__ float sigm(float x) { return __builtin_amdgcn_rcpf(1.0f + __expf(-x)); }

__device__ __forceinline__ void stage_rstd(const float* SS, int pm, int tid_, PG8_LAS float* RSL) {
    const int r = tid_ >> 1, h = tid_ & 1;
    f32x4 t = {0.f, 0.f, 0.f, 0.f};
    if (pm < 32) { const f32x4* sp = (const f32x4*)(SS + (size_t)(pm * 256 + r) * 32 + h * 16); t = (sp[0] + sp[1]) + (sp[2] + sp[3]); }
    else if (r < 128) { const f32x4* sp = (const f32x4*)(SS + (size_t)8192 * 32 + (size_t)r * 128 + h * 64);
#pragma unroll
        for (int i = 0; i < 16; ++i) t += sp[i]; }
    float s_ = (t[0] + t[1]) + (t[2] + t[3]);
    s_ += dppf<0xB1>(s_);
    if (h == 0) RSL[r] = __builtin_amdgcn_rsqf(s_ * (1.0f / 2048.0f) + 1e-6f);
}
struct EpiBf {
    static constexpr bool PERM = true, AFTER_DRAIN = false, HAS_MID = true, PERMA = false, PERMB = false;
    u32x4* GT; int gt0;
    bf16_t* O; int ldc; float* GK; int gkt; const float* SS; PG8_LAS float* RSL;
    __device__ __forceinline__ void mid(f32x4 (&acc)[2][2][4][2], const Unit& u, int wr, int wc, int fr, int fq) const {
        asm volatile("" : "+v"(fr));
        stage_rstd(SS, u.pm, (wr * 4 + wc) * 64 + fq * 16 + fr, RSL);
    }
    __device__ __forceinline__ void operator()(const f32x4 (&acc)[2][2][4][2], const Unit& u, int wr, int wc, int fr, int fq) const {
        const int row0 = u.pm * BM + wr * 64 + fr;
        float rs[2][4];
#pragma unroll
        for (int ai = 0; ai < 2; ++ai)
#pragma unroll
            for (int m = 0; m < 4; ++m) rs[ai][m] = RSL[wr * 64 + fr + ai * HALF + m * 16];
        if (u.pn == gkt) {
            if (wc == 0 && fq < 2) {
#pragma unroll
                for (int ai = 0; ai < 2; ++ai)
#pragma unroll
                    for (int m = 0; m < 4; ++m) { float* gp = GK + (size_t)(row0 + ai * HALF + m * 16) * 16 + 8 * fq;
                        *(f32x4*)(gp) = acc[ai][0][m][0] * rs[ai][m]; *(f32x4*)(gp + 4) = acc[ai][0][m][1] * rs[ai][m]; }
            }
            return;
        }
        if (GT != nullptr && u.pm < 32 && u.pn >= gt0 && u.pn < gt0 + 16) {
            u32x4* gp = GT + ((size_t)(u.pm * 16 + (u.pn - gt0)) * 16) * 512 + (wr * 4 + wc) * 64 + fq * 16 + fr;
#pragma unroll
            for (int ai = 0; ai < 2; ++ai)
#pragma unroll
                for (int m = 0; m < 4; ++m) { const float r = rs[ai][m];
#pragma unroll
                    for (int bj = 0; bj < 2; ++bj) { const f32x4 v0 = acc[ai][bj][m][0] * r, v1 = acc[ai][bj][m][1] * r;
                        u32x4 w; w.x = cvt_pk_bf16(v0[0], v0[1]); w.y = cvt_pk_bf16(v0[2], v0[3]); w.z = cvt_pk_bf16(v1[0], v1[1]); w.w = cvt_pk_bf16(v1[2], v1[3]);
                        gp[((ai * 4 + m) * 2 + bj) * 512] = w; } }
            return;
        }
        const int col0 = u.pn * BM + wc * 32 + 8 * fq;
#pragma unroll
        for (int ai = 0; ai < 2; ++ai)
#pragma unroll
            for (int m = 0; m < 4; ++m) { bf16_t* rowp = O + (size_t)(row0 + ai * HALF + m * 16) * ldc + col0; const float r = rs[ai][m];
#pragma unroll
                for (int bj = 0; bj < 2; ++bj) { const f32x4 v0 = acc[ai][bj][m][0] * r, v1 = acc[ai][bj][m][1] * r;
                    u32x4 w; w.x = cvt_pk_bf16(v0[0], v0[1]); w.y = cvt_pk_bf16(v0[2], v0[3]); w.z = cvt_pk_bf16(v1[0], v1[1]); w.w = cvt_pk_bf16(v1[2], v1[3]);
                    *(u32x4*)(rowp + bj * HALF) = w; } }
    }
};
struct EpiMix {
    static constexpr bool PERM = true, AFTER_DRAIN = false, HAS_MID = true, PERMA = false, PERMB = false;
    const u32x4* GT; bf16_t* O;
    __device__ __forceinline__ float rat(float gb, float ga) const { return (1.0f + __expf(-gb)) * __builtin_amdgcn_rcpf(1.0f + __expf(-ga)); }
    __device__ __forceinline__ void mid(f32x4 (&acc)[2][2][4][2], const Unit& u, int wr, int wc, int fr, int fq) const {
        asm volatile("" : "+v"(fr));
        const u32x4* ga_p = GT + ((size_t)(u.pm * 16 + u.pn) * 16) * 512 + (wr * 4 + wc) * 64 + fq * 16 + fr; const u32x4* gb_p = ga_p + (size_t)8 * 16 * 512;
#pragma unroll
        for (int q4 = 0; q4 < 4; ++q4) {
            u32x4 gav[4], gbv[4];
#pragma unroll
            for (int k = 0; k < 4; ++k) { gav[k] = ga_p[(q4 * 4 + k) * 512]; gbv[k] = gb_p[(q4 * 4 + k) * 512]; }
#pragma unroll
            for (int k = 0; k < 4; ++k) { const int gi = q4 * 4 + k, ai = gi >> 3, m = (gi >> 1) & 3, bj = gi & 1;
                const u32x4 ga = gav[k], gb = gbv[k];
                f32x4 a0 = acc[ai][bj][m][0], a1 = acc[ai][bj][m][1];
                a0[0] *= rat(bfl(gb.x), bfl(ga.x)); a0[1] *= rat(bfh(gb.x), bfh(ga.x)); a0[2] *= rat(bfl(gb.y), bfl(ga.y)); a0[3] *= rat(bfh(gb.y), bfh(ga.y));
                a1[0] *= rat(bfl(gb.z), bfl(ga.z)); a1[1] *= rat(bfh(gb.z), bfh(ga.z)); a1[2] *= rat(bfl(gb.w), bfl(ga.w)); a1[3] *= rat(bfh(gb.w), bfh(ga.w));
                acc[ai][bj][m][0] = a0; acc[ai][bj][m][1] = a1; }
            asm volatile("" ::: "memory"); __builtin_amdgcn_sched_barrier(0);
        }
    }
    __device__ __forceinline__ void operator()(const f32x4 (&acc)[2][2][4][2], const Unit& u, int wr, int wc, int fr, int fq) const {
        const int row0 = u.pm * BM + wr * 64 + fr, col0 = u.pn * BM + wc * 32 + 8 * fq;
        const u32x4* gb_p = GT + ((size_t)(u.pm * 16 + 8 + u.pn) * 16) * 512 + (wr * 4 + wc) * 64 + fq * 16 + fr;
#pragma unroll
        for (int h2 = 0; h2 < 2; ++h2) {
            u32x4 gv[8];
#pragma unroll
            for (int k = 0; k < 8; ++k) gv[k] = gb_p[(h2 * 8 + k) * 512];
#pragma unroll
            for (int k = 0; k < 8; ++k) { const int gi = h2 * 8 + k, ai = gi >> 3, m = (gi >> 1) & 3, bj = gi & 1;
                const size_t row = (size_t)(row0 + ai * HALF + m * 16); const int c = col0 + bj * HALF;
                const u32x4 gw = gv[k];
                const f32x4 a0 = acc[ai][bj][m][0], a1 = acc[ai][bj][m][1];
                u32x4 w; w.x = cvt_pk_bf16(sigm(bfl(gw.x)) * a0[0], sigm(bfh(gw.x)) * a0[1]); w.y = cvt_pk_bf16(sigm(bfl(gw.y)) * a0[2], sigm(bfh(gw.y)) * a0[3]);
                w.z = cvt_pk_bf16(sigm(bfl(gw.z)) * a1[0], sigm(bfh(gw.z)) * a1[1]); w.w = cvt_pk_bf16(sigm(bfl(gw.w)) * a1[2], sigm(bfh(gw.w)) * a1[3]);
                *(u32x4*)(O + row * 2048 + c) = w; }
            asm volatile("" ::: "memory");
        }
    }
};
__device__ __forceinline__ float dpp_shr1(float v) { return __builtin_bit_cast(float, __builtin_amdgcn_update_dpp(0, __builtin_bit_cast(int, v), 0x111, 0xf, 0xf, true)); }
__device__ __forceinline__ float dpp_shr2(float v) { return __builtin_bit_cast(float, __builtin_amdgcn_update_dpp(0, __builtin_bit_cast(int, v), 0x112, 0xf, 0xf, true)); }
__device__ __forceinline__ float dpp_shl15(float v) { return __builtin_bit_cast(float, __builtin_amdgcn_update_dpp(0, __builtin_bit_cast(int, v), 0x10F, 0xf, 0xf, true)); }
__device__ __forceinline__ float dpp_shl14(float v) { return __builtin_bit_cast(float, __builtin_amdgcn_update_dpp(0, __builtin_bit_cast(int, v), 0x10E, 0xf, 0xf, true)); }
__device__ __forceinline__ float gelu_t(float x) { const float z = 1.5957691216057308f * (x + 0.044715f * x * x * x); return x * __builtin_amdgcn_rcpf(1.0f + __expf(-z)); }
struct EpiUp {
    static constexpr bool PERM = true, AFTER_DRAIN = false, HAS_MID = true, PERMA = true, PERMB = true;
    bf16_t* ACT; bf16_t* U; float* RAWB; const float* SS; const float* wconv; const float* bconv; PG8_LAS float* XCH;
    __device__ __forceinline__ void mid(f32x4 (&acc)[2][2][4][2], const Unit& u, int wr, int wc, int fr, int fq) const {
        asm volatile("" : "+v"(fr));
        stage_rstd(SS, u.pm, (wr * 4 + wc) * 64 + fq * 16 + fr, XCH + 3072);
    }
    __device__ __forceinline__ void operator()(const f32x4 (&acc)[2][2][4][2], const Unit& u, int wr, int wc, int fr, int fq) const {
        asm volatile("" : "+v"(fr), "+v"(fq));
        const int row0 = u.pm * BM + wr * 64 + 4 * fr, cl = wc * 32 + 16 * (fq & 1) + 4 * (fq >> 1);
        float rs[2][4];
#pragma unroll
        for (int ai = 0; ai < 2; ++ai) { const f32x4 r4 = *(const PG8_LAS f32x4*)(XCH + 3072 + ai * HALF + wr * 64 + 4 * fr);
#pragma unroll
            for (int m = 0; m < 4; ++m) rs[ai][m] = r4[m]; }
        if (u.pm == 32) {
#pragma unroll
            for (int ai = 0; ai < 2; ++ai)
#pragma unroll
                for (int m = 0; m < 4; ++m) { const int row = row0 + ai * HALF + m;
                    if (row < 8320) {
#pragma unroll
                        for (int bj = 0; bj < 2; ++bj)
#pragma unroll
                            for (int n = 0; n < 2; ++n) { const f32x4 v0 = acc[ai][bj][m][n] * rs[ai][m];
                                u32x2 w; w.x = cvt_pk_bf16(v0[0], v0[1]); w.y = cvt_pk_bf16(v0[2], v0[3]);
                                *(u32x2*)(U + (size_t)row * 11264 + bj * 5632 + 128 * u.pn + cl + 8 * n) = w; } } }
            return;
        }
        if (fr == 15) {
#pragma unroll
            for (int ai = 0; ai < 2; ++ai)
#pragma unroll
                for (int bj = 0; bj < 2; ++bj)
#pragma unroll
                    for (int n = 0; n < 2; ++n) { PG8_LAS float* xp = XCH + ((ai * 2 + wr) * 2) * 256 + bj * 128 + cl + 8 * n;
                        *(PG8_LAS f32x4*)xp = acc[ai][bj][2][n] * rs[ai][2]; *(PG8_LAS f32x4*)(xp + 256) = acc[ai][bj][3][n] * rs[ai][3]; }
            if (wr == 1) {
#pragma unroll
                for (int bj = 0; bj < 2; ++bj)
#pragma unroll
                    for (int n = 0; n < 2; ++n) { float* rp = RAWB + ((size_t)(u.pm * 44 + u.pn) * 4 + 2) * 256 + bj * 128 + cl + 8 * n;
                        *(f32x4*)rp = acc[1][bj][2][n] * rs[1][2]; *(f32x4*)(rp + 256) = acc[1][bj][3][n] * rs[1][3]; }
            }
        }
        if (wr == 0 && fr == 0) {
#pragma unroll
            for (int bj = 0; bj < 2; ++bj)
#pragma unroll
                for (int n = 0; n < 2; ++n) { float* rp = RAWB + ((size_t)(u.pm * 44 + u.pn) * 4) * 256 + bj * 128 + cl + 8 * n;
                    *(f32x4*)rp = acc[0][bj][0][n] * rs[0][0]; *(f32x4*)(rp + 256) = acc[0][bj][1][n] * rs[0][1]; }
        }
        {
            PG8_LAS float* WL = XCH + 2048;
            const int tid_ = (wr * 4 + wc) * 64 + fq * 16 + fr, v = tid_ >> 6, c2 = (tid_ & 63) * 2;
            const float* src = (v & 3) == 3 ? bconv + (v >> 2) * 5632 : wconv + (v & 3) * 11264 + (v >> 2) * 5632;
            *(PG8_LAS f32x2*)(WL + v * 128 + c2) = *(const f32x2*)(src + 128 * u.pn + c2);
        }
        asm volatile("s_waitcnt lgkmcnt(0)" ::: "memory"); __builtin_amdgcn_s_barrier(); asm volatile("" ::: "memory");
        unsigned hold[2][4];
        const bool upper = fq >= 2;
        const int cstore = wc * 32 + 16 * (fq & 1);
#pragma unroll
        for (int nn = 0; nn < 4; ++nn) {
            const int n = nn >> 1, eh = nn & 1, j0 = 128 * u.pn + cl + 8 * n + 2 * eh;
            const PG8_LAS float* wl = XCH + 2048 + cl + 8 * n + 2 * eh;
            const f32x2 w0v = *(const PG8_LAS f32x2*)(wl), w1v = *(const PG8_LAS f32x2*)(wl + 128), w2v = *(const PG8_LAS f32x2*)(wl + 256), bv = *(const PG8_LAS f32x2*)(wl + 384);
            const f32x2 w0g = *(const PG8_LAS f32x2*)(wl + 512), w1g = *(const PG8_LAS f32x2*)(wl + 640), w2g = *(const PG8_LAS f32x2*)(wl + 768), bg = *(const PG8_LAS f32x2*)(wl + 896);
#pragma unroll
            for (int ai = 0; ai < 2; ++ai) {
                const int q = ai * 2 + wr;
                f32x2 xv[4], xg[4];
                const f32x4 r4 = *(const PG8_LAS f32x4*)(XCH + 3072 + ai * HALF + wr * 64 + 4 * fr);
#pragma unroll
                for (int m = 0; m < 4; ++m) { const float r = r4[m];
                    xv[m] = (f32x2){acc[ai][0][m][n][2 * eh] * r, acc[ai][0][m][n][2 * eh + 1] * r}; xg[m] = (f32x2){acc[ai][1][m][n][2 * eh] * r, acc[ai][1][m][n][2 * eh + 1] * r}; }
                f32x2 l2v = {0.f, 0.f}, l3v = l2v, l2g = l2v, l3g = l2v;
                if (q > 0) { const PG8_LAS float* xp = XCH + ((q - 1) * 2) * 256 + cl + 8 * n + 2 * eh;
                    l2v = *(const PG8_LAS f32x2*)xp; l3v = *(const PG8_LAS f32x2*)(xp + 256); l2g = *(const PG8_LAS f32x2*)(xp + 128); l3g = *(const PG8_LAS f32x2*)(xp + 256 + 128); }
                const bool f0 = fr == 0;
                const f32x2 s3v = {dpp_shr1(xv[3][0]) + (f0 ? l3v[0] : 0.f), dpp_shr1(xv[3][1]) + (f0 ? l3v[1] : 0.f)}, s2v = {dpp_shr1(xv[2][0]) + (f0 ? l2v[0] : 0.f), dpp_shr1(xv[2][1]) + (f0 ? l2v[1] : 0.f)};
                const f32x2 s3g = {dpp_shr1(xg[3][0]) + (f0 ? l3g[0] : 0.f), dpp_shr1(xg[3][1]) + (f0 ? l3g[1] : 0.f)}, s2g = {dpp_shr1(xg[2][0]) + (f0 ? l2g[0] : 0.f), dpp_shr1(xg[2][1]) + (f0 ? l2g[1] : 0.f)};
                unsigned pwv[4];
#pragma unroll
                for (int m = 0; m < 4; ++m) {
                    const f32x2 p1v = m == 0 ? s3v : xv[m - 1 < 0 ? 0 : m - 1], p2v = m == 0 ? s2v : (m == 1 ? s3v : xv[m - 2 < 0 ? 0 : m - 2]);
                    const f32x2 p1g = m == 0 ? s3g : xg[m - 1 < 0 ? 0 : m - 1], p2g = m == 0 ? s2g : (m == 1 ? s3g : xg[m - 2 < 0 ? 0 : m - 2]);
                    const f32x2 vc = w0v * p2v + w1v * p1v + w2v * xv[m] + bv, gc = w0g * p2g + w1g * p1g + w2g * xg[m] + bg;
                    const f32x2 gw = (gc * gc) * (-0.10294324f) + (-2.3022082f), gz = gc * gw;
                    f32x2 gd; gd[0] = __builtin_amdgcn_rcpf(1.0f + __builtin_amdgcn_exp2f(gz[0])); gd[1] = __builtin_amdgcn_rcpf(1.0f + __builtin_amdgcn_exp2f(gz[1]));
                    const f32x2 av = (gc * gd) * vc;
                    pwv[m] = cvt_pk_bf16(av[0], av[1]);
                    if (eh == 0) hold[ai][m] = pwv[m];
                }
                if (eh == 1) {
#pragma unroll
                    for (int pr = 0; pr < 2; ++pr) {
                        unsigned a0 = hold[ai][2 * pr], a1 = pwv[2 * pr], b0 = hold[ai][2 * pr + 1], b1 = pwv[2 * pr + 1];
                        asm volatile("s_nop 1" : "+v"(a0), "+v"(a1), "+v"(b0), "+v"(b1));
                        { auto r = __builtin_amdgcn_permlane32_swap(a0, b0, false, false); a0 = r[0]; b0 = r[1]; }
                        { auto r = __builtin_amdgcn_permlane32_swap(a1, b1, false, false); a1 = r[0]; b1 = r[1]; }
                        if (!(q == 0 && pr == 0 && f0)) { u32x4 w; w.x = a0; w.y = a1; w.z = b0; w.w = b1;
                            *(u32x4*)(ACT + (size_t)(row0 + ai * HALF + 2 * pr + (upper ? 1 : 0)) * 5632 + 128 * u.pn + cstore + 8 * n) = w; }
                    }
                }
            }
            __builtin_amdgcn_sched_barrier(0);
        }
    }
};
struct EpiRes {
    static constexpr bool PERM = true, AFTER_DRAIN = false, HAS_MID = false, PERMA = false, PERMB = false;
    bf16_t* XB; float* Yf; float* SS;
    __device__ __forceinline__ void operator()(const f32x4 (&acc)[2][2][4][2], const Unit& u, int wr, int wc, int fr, int fq) const {
        const int row0 = u.pm * BM + wr * 64 + fr, col0 = u.pn * BM + wc * 32 + 8 * fq;
#pragma unroll
        for (int ai = 0; ai < 2; ++ai)
#pragma unroll
            for (int m = 0; m < 4; ++m) { const int row = row0 + ai * HALF + m * 16; const size_t off = (size_t)row * 2048 + col0; float ss = 0.f;
#pragma unroll
                for (int bj = 0; bj < 2; ++bj) { const u32x4 xw = *(const u32x4*)(XB + off + bj * HALF);
                    f32x4 y0 = acc[ai][bj][m][0], y1 = acc[ai][bj][m][1];
                    y0[0] += bfl(xw.x); y0[1] += bfh(xw.x); y0[2] += bfl(xw.y); y0[3] += bfh(xw.y); y1[0] += bfl(xw.z); y1[1] += bfh(xw.z); y1[2] += bfl(xw.w); y1[3] += bfh(xw.w);
                    if (Yf) { *(f32x4*)(Yf + off + bj * HALF) = y0; *(f32x4*)(Yf + off + bj * HALF + 4) = y1; }
                    else { u32x4 w; w.x = cvt_pk_bf16(y0[0], y0[1]); w.y = cvt_pk_bf16(y0[2], y0[3]); w.z = cvt_pk_bf16(y1[0], y1[1]); w.w = cvt_pk_bf16(y1[2], y1[3]);
                        *(u32x4*)(XB + off + bj * HALF) = w;
                        const float r0 = bfl(w.x), r1 = bfh(w.x), r2 = bfl(w.y), r3 = bfh(w.y), r4 = bfl(w.z), r5 = bfh(w.z), r6 = bfl(w.w), r7 = bfh(w.w);
                        ss += ((r0 * r0 + r1 * r1) + (r2 * r2 + r3 * r3)) + ((r4 * r4 + r5 * r5) + (r6 * r6 + r7 * r7)); } }
                if (!Yf) { ss = xrows_sum(ss); if (fq == 0) SS[(size_t)row * 32 + u.pn * 4 + wc] = ss; } }
    }
};
template <class Epi, class Sched, bool ALIGN_EPI = false, bool SP2 = false>
__device__ __forceinline__ void gemm_phase(PG8_LAS unsigned char* lds, const Gemm g, const Sched& S, const Epi& E) {
    const int tid = ltid(), wid = __builtin_amdgcn_readfirstlane(tid >> 6), lane = tid & 63, wr = wid >> 2, wc = wid & 3, fr = lane & 15, fq = lane >> 4;
    const int K = g.K, nt = K / BK;
    unsigned voffA[2], voffB[2];
#pragma unroll
    for (int i = 0; i < 2; ++i) { int R, C; stage_rc(tid * 16 + i * 8192, R, C); const int Rb = Epi::PERM ? ((R & ~31) + (Epi::PERMB ? perm32x(R & 31) : perm32(R & 31))) : R;
        const int Ra = Epi::PERMA ? ((R & ~63) + 4 * (R & 15) + ((R >> 4) & 3)) : R;
        voffA[i] = (unsigned)(Ra * K + C) * 2u; voffB[i] = (unsigned)(Rb * K + C) * 2u; }
    const size_t kstep = (size_t)(BK * 2);
    const size_t hstep = (size_t)HALF * K * 2;
    const size_t tstep = 2 * hstep;
    const unsigned ldsw = (unsigned)wid * 1024u;
    const int aoff = lds_byte(wr * 64 + fr, fq * 8), boff = lds_byte(wc * 32 + fr, fq * 8);
#define PG8_SA(b, h) (((b) * 2 + (h)) * HTB)
#define PG8_SB(b, h) ((4 + (b) * 2 + (h)) * HTB)
#define PG8_STAGE(bufoff, gbase, voff) do { _Pragma("unroll") for (int _i = 0; _i < 2; ++_i) \
        __builtin_amdgcn_global_load_lds((const unsigned*)((const char*)(gbase) + (voff)[_i]), (PG8_LAS unsigned*)(lds + (bufoff) + ldsw + _i * 8192), 16, 0, 0); } while (0)
#define PG8_LDA(dst, b, h) do { _Pragma("unroll") for (int m = 0; m < 4; ++m) _Pragma("unroll") for (int k = 0; k < 2; ++k) dst[m][k] = *(const PG8_LAS bf16x8*)(lds + PG8_SA(b, h) + aoff + m * 2048 + k * 1024); } while (0)
#define PG8_LDB(dst, b, h) do { _Pragma("unroll") for (int n = 0; n < 2; ++n) _Pragma("unroll") for (int k = 0; k < 2; ++k) dst[n][k] = *(const PG8_LAS bf16x8*)(lds + PG8_SB(b, h) + boff + n * 2048 + k * 1024); } while (0)
#define PG8_MMA(ai, bj, At, Bt) do { __builtin_amdgcn_s_setprio(1); _Pragma("unroll") for (int k = 0; k < 2; ++k) _Pragma("unroll") for (int m = 0; m < 4; ++m) _Pragma("unroll") for (int n = 0; n < 2; ++n) \
        acc[ai][bj][m][n] = __builtin_amdgcn_mfma_f32_16x16x32_bf16(Bt[n][k], At[m][k], acc[ai][bj][m][n], 0, 0, 0); __builtin_amdgcn_s_setprio(0); } while (0)
#define PG8_WAIT_V(n) asm volatile("s_waitcnt vmcnt(" #n ")" ::: "memory")
#define PG8_WAIT_L(n) asm volatile("s_waitcnt lgkmcnt(" #n ")" ::: "memory")
#define PG8_BAR __builtin_amdgcn_s_barrier()
#define PG8_SCHED __builtin_amdgcn_sched_barrier(0)
    Unit cur, nxt; int ui = 0;
    if (!S.next(0, cur)) return;
    f32x4 acc[2][2][4][2];
#pragma unroll
    for (int a = 0; a < 2; ++a)
#pragma unroll
        for (int b = 0; b < 2; ++b)
#pragma unroll
            for (int m = 0; m < 4; ++m)
#pragma unroll
                for (int n = 0; n < 2; ++n) acc[a][b][m][n] = (f32x4){0.f, 0.f, 0.f, 0.f};
    bf16x8 At[4][2], B0[2][2], B1[2][2];
    const char* cA = (const char*)g.A + (size_t)cur.pm * tstep; const char* cB = (const char*)g.Bt + (size_t)cur.pn * tstep;
    S.a_ready(cur);
    if constexpr (SP2) {
        PG8_STAGE(PG8_SB(0, 0), cB, voffB); PG8_STAGE(PG8_SB(0, 1), cB + hstep, voffB); PG8_STAGE(PG8_SA(0, 0), cA, voffA); PG8_STAGE(PG8_SA(0, 1), cA + hstep, voffA);
        if (wr == 1) PG8_BAR;
        PG8_WAIT_V(2); PG8_BAR;
        PG8_STAGE(PG8_SB(1, 0), cB + kstep, voffB); PG8_STAGE(PG8_SA(1, 0), cA + kstep, voffA); PG8_STAGE(PG8_SB(1, 1), cB + hstep + kstep, voffB);
        PG8_WAIT_V(6); PG8_BAR;
    } else {
        PG8_STAGE(PG8_SB(0, 0), cB, voffB); PG8_STAGE(PG8_SA(0, 0), cA, voffA); PG8_STAGE(PG8_SB(0, 1), cB + hstep, voffB); PG8_STAGE(PG8_SA(0, 1), cA + hstep, voffA);
        if (wr == 1) PG8_BAR;
        PG8_WAIT_V(4); PG8_BAR;
        PG8_STAGE(PG8_SB(1, 0), cB + kstep, voffB); PG8_STAGE(PG8_SA(1, 0), cA + kstep, voffA); PG8_STAGE(PG8_SB(1, 1), cB + hstep + kstep, voffB);
        PG8_WAIT_V(6); PG8_BAR;
    }
    for (;;) {
        const bool has_next = S.next(ui + 1, nxt);
        const char* nA = has_next ? (const char*)g.A + (size_t)nxt.pm * tstep : cA; const char* nB = has_next ? (const char*)g.Bt + (size_t)nxt.pn * tstep : cB;
        for (int t = 0; t < nt; t += 2) {
            const bool last = (t == nt - 2);
            const char* a1 = cA + (size_t)(t + 1) * kstep;
            const char* a2 = last ? nA : cA + (size_t)(t + 2) * kstep; const char* b2 = last ? nB : cB + (size_t)(t + 2) * kstep;
            const char* a3 = a2 + kstep; const char* b3 = b2 + kstep;
            if (last && has_next) S.a_ready(nxt);
            if constexpr (Epi::HAS_MID) { if (t == (nt >> 1)) { PG8_SCHED; E.mid(acc, cur, wr, wc, fr, fq); PG8_SCHED; } }
            if constexpr (SP2) {
            PG8_LDB(B0, 0, 0); PG8_LDB(B1, 0, 1); PG8_SCHED; PG8_LDA(At, 0, 0); PG8_STAGE(PG8_SA(1, 1), a1 + hstep, voffA);
            PG8_WAIT_V(8); PG8_WAIT_L(0); PG8_BAR; PG8_MMA(0, 0, At, B0); PG8_MMA(0, 1, At, B1); PG8_BAR; PG8_SCHED;
            PG8_LDA(At, 0, 1); PG8_STAGE(PG8_SB(0, 0), b2, voffB); PG8_STAGE(PG8_SB(0, 1), b2 + hstep, voffB); PG8_STAGE(PG8_SA(0, 0), a2, voffA);
            PG8_WAIT_V(8); PG8_WAIT_L(0); PG8_BAR; PG8_MMA(1, 0, At, B0); PG8_MMA(1, 1, At, B1); PG8_BAR; PG8_SCHED;
            PG8_LDB(B0, 1, 0); PG8_LDB(B1, 1, 1); PG8_SCHED; PG8_LDA(At, 1, 0); PG8_STAGE(PG8_SA(0, 1), a2 + hstep, voffA);
            PG8_WAIT_V(8); PG8_WAIT_L(0); PG8_BAR; PG8_MMA(0, 0, At, B0); PG8_MMA(0, 1, At, B1); PG8_BAR; PG8_SCHED;
            PG8_LDA(At, 1, 1); PG8_STAGE(PG8_SB(1, 0), b3, voffB); PG8_STAGE(PG8_SB(1, 1), b3 + hstep, voffB); PG8_STAGE(PG8_SA(1, 0), a3, voffA);
            PG8_WAIT_V(8); PG8_WAIT_L(0); PG8_BAR; PG8_MMA(1, 0, At, B0); PG8_MMA(1, 1, At, B1); PG8_BAR; PG8_SCHED;
            } else {
            PG8_LDB(B0, 0, 0); PG8_SCHED; PG8_LDA(At, 0, 0); PG8_STAGE(PG8_SA(1, 1), a1 + hstep, voffA);
            PG8_WAIT_L(8); PG8_BAR; PG8_WAIT_L(0); PG8_MMA(0, 0, At, B0); PG8_BAR; PG8_SCHED;
            PG8_LDB(B1, 0, 1); PG8_STAGE(PG8_SB(0, 0), b2, voffB);
            PG8_BAR; PG8_WAIT_L(0); PG8_MMA(0, 1, At, B1); PG8_BAR;
            PG8_LDA(At, 0, 1); PG8_STAGE(PG8_SA(0, 0), a2, voffA);
            PG8_BAR; PG8_WAIT_L(0); PG8_MMA(1, 0, At, B0); PG8_BAR; PG8_SCHED;
            PG8_STAGE(PG8_SB(0, 1), b2 + hstep, voffB);
            PG8_WAIT_V(6); PG8_BAR; PG8_MMA(1, 1, At, B1); PG8_BAR;
            PG8_LDB(B0, 1, 0); PG8_SCHED; PG8_LDA(At, 1, 0); PG8_STAGE(PG8_SA(0, 1), a2 + hstep, voffA);
            PG8_WAIT_L(8); PG8_BAR; PG8_WAIT_L(0); PG8_MMA(0, 0, At, B0); PG8_BAR; PG8_SCHED;
            PG8_LDB(B1, 1, 1); PG8_STAGE(PG8_SB(1, 0), b3, voffB);
            PG8_BAR; PG8_WAIT_L(0); PG8_MMA(0, 1, At, B1); PG8_BAR;
            PG8_LDA(At, 1, 1); PG8_STAGE(PG8_SA(1, 0), a3, voffA);
            PG8_BAR; PG8_WAIT_L(0); PG8_MMA(1, 0, At, B0); PG8_BAR; PG8_SCHED;
            PG8_STAGE(PG8_SB(1, 1), b3 + hstep, voffB);
            PG8_WAIT_V(6); PG8_BAR; PG8_MMA(1, 1, At, B1); PG8_BAR;
            }
        }
        if constexpr (ALIGN_EPI) { if (wr == 0) PG8_BAR; }
        if constexpr (!Epi::AFTER_DRAIN) { E(acc, cur, wr, wc, fr, fq); S.done(cur); }
        if (!has_next) break;
#pragma unroll
        for (int a = 0; a < 2; ++a)
#pragma unroll
            for (int b = 0; b < 2; ++b)
#pragma unroll
                for (int m = 0; m < 4; ++m)
#pragma unroll
                    for (int n = 0; n < 2; ++n) acc[a][b][m][n] = (f32x4){0.f, 0.f, 0.f, 0.f};
        cur = nxt; cA = nA; cB = nB; ++ui;
        if constexpr (ALIGN_EPI) { if (wr == 1) PG8_BAR; }
    }
    PG8_WAIT_V(0);
    if constexpr (!ALIGN_EPI) { if (wr == 0) PG8_BAR; }
    PG8_BAR;
    if constexpr (Epi::AFTER_DRAIN) { E.fused(acc, cur, wr, wc, fr, fq, lds, wid, lane); S.done(cur); }
#undef PG8_SA
#undef PG8_SB
#undef PG8_STAGE
#undef PG8_LDA
#undef PG8_LDB
#undef PG8_MMA
#undef PG8_WAIT_V
#undef PG8_WAIT_L
#undef PG8_BAR
#undef PG8_SCHED
}
}

constexpr int D = 2048, MP = 8192, MS = 128, MREAL = 8320, MPAD = 8448, SEQ = 4096, DEPTH = 4;
constexpr int NIN_SRC = 8720, NIN = 8960;
constexpr int C_QA = 0, C_KA = 1024, C_VA = 1280, C_QB = 1536, C_KB = 2048, C_VB = 2560, C_RB = 3584, C_GA = 4608, C_GB = 6656, C_GK = 8704;
constexpr int DFF = 5632, NUP = 11264;
constexpr int GC = 128, NCH = SEQ / GC;
constexpr float EPS = 1e-6f;
constexpr size_t O_Y = 0, O_KP = 17039360, O_VP = 17301504, O_GP = 17563648, O_CP = 18612224, O_KS = 18792448, O_VS = 22986752, O_GS = 27181056, O_CS = 43958272, O_END = 46841856;
constexpr size_t al256(size_t x) { return (x + 255) & ~(size_t)255; }
constexpr size_t WS_CTL = 0, CTL_BYTES = 1u << 20;
constexpr size_t WS_BIAS = WS_CTL + CTL_BYTES;
constexpr size_t WS_WIN = WS_BIAS + 8192;
constexpr size_t WS_WOA = WS_WIN + (size_t)NIN * D * 2;
constexpr size_t WS_WOB = WS_WOA + (size_t)1024 * 2;
constexpr size_t WS_WOUT = WS_WOA + (size_t)2048 * 2048 * 2;
constexpr size_t WS_WUP = WS_WOUT + (size_t)2048 * 2048 * 2;
constexpr size_t WS_WDN = WS_WUP + (size_t)NUP * D * 2;
constexpr size_t WS_X = WS_WDN + (size_t)2048 * DFF * 2;
constexpr size_t WS_H = WS_X + (size_t)MPAD * D * 4;
constexpr size_t WS_PROJ = WS_H + (size_t)MPAD * D * 2;
constexpr size_t WS_GK = WS_PROJ + (size_t)MPAD * NIN * 2;
constexpr size_t WS_OA = WS_GK + (size_t)MPAD * 16 * 4;
constexpr size_t WS_OB = WS_OA + (size_t)1024 * 2;
constexpr size_t WS_T = WS_OA + (size_t)MPAD * 2048 * 2;
constexpr size_t WS_MIX = WS_T + (size_t)MPAD * D * 4;
constexpr size_t WS_U = WS_MIX + (size_t)MPAD * D * 2;
constexpr size_t WS_ACT = WS_U + (size_t)MPAD * NUP * 2;
constexpr size_t WS_GU = WS_ACT + (size_t)MPAD * DFF * 2;
constexpr size_t WS_GDL = WS_GU + (size_t)8 * NCH * 32768 * 4;
constexpr size_t WS_GS = WS_GDL + (size_t)8 * NCH * 128 * 4;
constexpr size_t WS_QT = WS_GS + (size_t)8 * NCH * 32768 * 2;
constexpr size_t WS_KT = WS_QT + (size_t)MP * 512 * 2;
constexpr size_t WS_SS1 = WS_KT + (size_t)MP * 512 * 2;
constexpr size_t WS_SS2 = WS_SS1 + (size_t)(MP * 32 + 128 * 128) * 4;
constexpr size_t WS_RS1 = WS_SS2 + (size_t)(MP * 32 + 128 * 128) * 4;
constexpr size_t WS_RS2 = WS_RS1 + (size_t)MPAD * 4;
constexpr size_t WS_W2 = al256(WS_RS2 + (size_t)MPAD * 4);
constexpr size_t WSET_BYTES = WS_X - WS_WIN;
constexpr size_t WS_RAWB = al256(WS_W2 + WSET_BYTES);
constexpr size_t WS_GT = al256(WS_RAWB + (size_t)32 * 44 * 4 * 256 * 4);
constexpr size_t WS_END = WS_GT + (size_t)32 * 16 * 131072;
static_assert(WS_WIN % 256 == 0 && WS_X % 256 == 0 && WS_PROJ % 256 == 0 && WS_GU % 256 == 0, "ws alignment");
constexpr int CW_BAR = 4096;
constexpr int RING_BYTES = 131072, LDS_BYTES = 147456, MISC_OFF = LDS_BYTES - 128;
constexpr int NPH = 11;

#define LAS __attribute__((address_space(3)))
typedef unsigned short bf16;
typedef unsigned v4u __attribute__((ext_vector_type(4)));
typedef unsigned v2u __attribute__((ext_vector_type(2)));
typedef float f32x4 __attribute__((ext_vector_type(4)));
typedef short bf16x8 __attribute__((ext_vector_type(8)));
__device__ __forceinline__ float bfl(unsigned w) { return __uint_as_float(w << 16); }
__device__ __forceinline__ float bfh(unsigned w) { return __uint_as_float(w & 0xffff0000u); }
__device__ __forceinline__ float bf1(bf16 b) { return __uint_as_float((unsigned)b << 16); }
typedef float f32x2_t __attribute__((ext_vector_type(2)));
typedef __bf16 bf16x2_t __attribute__((ext_vector_type(2)));
__device__ __forceinline__ unsigned pk2(float lo, float hi) { const f32x2_t v = {lo, hi}; return __builtin_bit_cast(unsigned, __builtin_convertvector(v, bf16x2_t)); }
__device__ __forceinline__ bf16 f2bf(float f) { return (bf16)(pk2(f, 0.f) & 0xffffu); }
__device__ __forceinline__ float wave_sum(float v) {
    return xrows_sum(red16_sum(v));
}
__device__ __forceinline__ float wave_max(float v) {
    return xrows_max(red16_max(v));
}
#define LDS_WAIT() asm volatile("s_waitcnt lgkmcnt(0)" ::: "memory")
#define XB_TMO      128
#define XB_XCNT(j)  (256  + 64 * (j))
#define XB_XSUB(j)  (1280 + 64 * (j))
#define XB_XGEN(j)  (2304 + 64 * (j))
#define XB_TOP      3328
#define XB_TOPGEN   3392
#define XCD_BAR_WORDS 3456
#define XB_SPIN_CAP (1u << 18)

__device__ __forceinline__ unsigned xb_ld(unsigned* p)              { return __hip_atomic_load(p, __ATOMIC_RELAXED, __HIP_MEMORY_SCOPE_AGENT); }
__device__ __forceinline__ unsigned xb_add(unsigned* p, unsigned v) { return __hip_atomic_fetch_add(p, v, __ATOMIC_RELAXED, __HIP_MEMORY_SCOPE_AGENT); }
__device__ __forceinline__ unsigned xb_xcc_id() { return (unsigned)__builtin_amdgcn_s_getreg((3 << 11) | 20) & 0xFu; }
#define XB_SPIN(cond, bar) do { unsigned _sp = 0; while (cond) { __builtin_amdgcn_s_sleep(1); \
    if ((++_sp & 255u) == 0u) { if (xb_ld(&(bar)[XB_TMO])) break; if (_sp > XB_SPIN_CAP) { atomicAdd(&(bar)[XB_TMO], 1u); break; } } } } while (0)

struct XcdBarrier {
    unsigned* bar; unsigned x;
    volatile LAS unsigned* st;
};

__device__ __forceinline__ XcdBarrier xcd_barrier_post(unsigned* bar, volatile LAS unsigned* st) {
    XcdBarrier b; b.bar = bar; b.x = xb_xcc_id(); b.st = st;
    if (threadIdx.x == 0) (void)xb_add(&bar[XB_XCNT(b.x)], 1u);
    return b;
}
__device__ __forceinline__ void xcd_barrier_complete(unsigned* bar, unsigned x, unsigned& nloc, unsigned& nx) {
    const unsigned G = gridDim.x * gridDim.y * gridDim.z;
    unsigned sum, cnt, mine, sp = 0u;
    for (;;) {
        sum = 0u; cnt = 0u; mine = 0u;
#pragma unroll
        for (unsigned j = 0; j < 16; ++j) { const unsigned c = xb_ld(&bar[XB_XCNT(j)]); sum += c; cnt += (c > 0u) ? 1u : 0u; mine = (j == x) ? c : mine; }
        if (sum == G) break;
        __builtin_amdgcn_s_sleep(1);
        if ((++sp & 255u) == 0u) { if (xb_ld(&bar[XB_TMO])) break; if (sp > XB_SPIN_CAP) { atomicAdd(&bar[XB_TMO], 1u); break; } }
    }
    nloc = mine > 0u ? mine : 1u; nx = cnt > 0u ? cnt : 1u;
}

__device__ __forceinline__ void xcd_barrier(const XcdBarrier& b) {
    asm volatile("s_waitcnt vmcnt(0)" ::: "memory");
    __syncthreads();
    if (threadIdx.x == 0) {
        unsigned* bar = b.bar;
        __builtin_amdgcn_s_waitcnt(0);
        unsigned nloc = b.st[0], nx = b.st[1];
        if (nloc == 0u) { xcd_barrier_complete(bar, b.x, nloc, nx); b.st[0] = nloc; b.st[1] = nx; }
        const unsigned old = xb_add(&bar[XB_XSUB(b.x)], 1u);
        const unsigned gen = old / nloc;
        if (old + 1u == (gen + 1u) * nloc) {
            __builtin_amdgcn_fence(__ATOMIC_RELEASE, "agent");
            asm volatile("s_waitcnt vmcnt(0)" ::: "memory");
            const unsigned og = xb_add(&bar[XB_TOP], 1u);
            const unsigned tg = og / nx;
            if (og + 1u == (tg + 1u) * nx) xb_add(&bar[XB_TOPGEN], 1u);
            else XB_SPIN(xb_ld(&bar[XB_TOPGEN]) == tg, bar);
            __builtin_amdgcn_fence(__ATOMIC_ACQUIRE, "agent");
            xb_add(&bar[XB_XGEN(b.x)], 1u);
            asm volatile("s_waitcnt vmcnt(0)" ::: "memory");
        } else {
            XB_SPIN(xb_ld(&bar[XB_XGEN(b.x)]) == gen, bar);
            __builtin_amdgcn_fence(__ATOMIC_ACQUIRE, "agent");
            asm volatile("s_waitcnt vmcnt(0)" ::: "memory");
        }
    }
    __syncthreads();
}

__device__ __forceinline__ bf16x8 as_frag(v4u w) { return __builtin_bit_cast(bf16x8, w); }
__device__ __forceinline__ float logsig(float x) { return fminf(x, 0.f) - __logf(1.0f + __expf(-fabsf(x))); }
__device__ __forceinline__ float sigm(float x) { return __builtin_amdgcn_rcpf(1.0f + __expf(-x)); }

__device__ __forceinline__ int win_src_col(int nd) { return nd < 4608 ? nd : (nd < 8704 ? nd + 16 : (nd < 8720 ? nd - 8704 + 4608 : -1)); }
constexpr int CV_IN = 32 * (NIN / 64), CV_OA = 16 * 32, CV_OUT = 32 * 32, CV_UP = 32 * (NUP / 64), CV_DN = (DFF / 64) * 32, CV_NIT = CV_IN + 2 * CV_OA + CV_OUT + CV_UP + CV_DN;
struct CvItem { const float* wp; const float* gp; bf16* op; int Nsrc, ldk; bool valid; };
__device__ __forceinline__ CvItem cvt_decode(int it, int lane, const float* w_in, const float* w_oa, const float* w_ob, const float* w_out, const float* w_up, const float* w_dn, unsigned char* wsb, const float* ln1, const float* ln2) {
    const int l = it / CV_NIT;
    unsigned char* wsw = wsb + ((l & 1) ? (WS_W2 - WS_WIN) : (size_t)0);
    const float* W; int ldk, Nsrc, kb, nb, map = 0; bf16* WT; const float* gain = nullptr; int r = it - l * CV_NIT;
    if (r < CV_IN) { W = w_in + (size_t)l * D * NIN_SRC; ldk = D; Nsrc = NIN_SRC; WT = (bf16*)(wsw + WS_WIN); kb = r / (NIN / 64); nb = r % (NIN / 64); map = 1; gain = ln1 + (size_t)l * D; }
    else if ((r -= CV_IN) < CV_OA) { W = w_oa + (size_t)l * 1024 * D; ldk = 2048; Nsrc = D; WT = (bf16*)(wsw + WS_WOA); kb = r / 32; nb = r % 32; }
    else if ((r -= CV_OA) < CV_OA) { W = w_ob + (size_t)l * 1024 * D; ldk = 2048; Nsrc = D; WT = (bf16*)(wsw + WS_WOB); kb = r / 32; nb = r % 32; }
    else if ((r -= CV_OA) < CV_OUT) { W = w_out + (size_t)l * D * D; ldk = D; Nsrc = D; WT = (bf16*)(wsw + WS_WOUT); kb = r / 32; nb = r % 32; }
    else if ((r -= CV_OUT) < CV_UP) { W = w_up + (size_t)l * D * NUP; ldk = D; Nsrc = NUP; WT = (bf16*)(wsw + WS_WUP); kb = r / (NUP / 64); nb = r % (NUP / 64); map = 2; gain = ln2 + (size_t)l * D; }
    else { r -= CV_UP; W = w_dn + (size_t)l * DFF * D; ldk = DFF; Nsrc = D; WT = (bf16*)(wsw + WS_WDN); kb = r / 32; nb = r % 32; }
    const int k0 = 64 * kb, n0 = 64 * nb, c = lane & 15, kr2 = lane >> 4, nd0 = n0 + 4 * c;
    const int ns = map == 1 ? win_src_col(nd0) : (map == 2 ? (((nd0 & 255) < 128) ? 128 * (nd0 >> 8) + (nd0 & 255) : DFF + 128 * (nd0 >> 8) + (nd0 & 255) - 128) : nd0);
    CvItem I; I.wp = W + (size_t)(k0 + 2 * kr2) * Nsrc + (ns >= 0 ? ns : 0); I.gp = gain ? gain + k0 + 2 * kr2 : nullptr; I.op = WT + (size_t)(n0 + (lane >> 3)) * ldk + k0 + 8 * (lane & 7);
    I.Nsrc = Nsrc; I.ldk = ldk; I.valid = ns >= 0; return I;
}
__device__ __forceinline__ void cvt_load(const CvItem& I, f32x4 (&va)[8], f32x4 (&vb)[8]) {
#pragma unroll
    for (int kk = 0; kk < 8; ++kk) { va[kk] = (f32x4){0.f, 0.f, 0.f, 0.f}; vb[kk] = va[kk];
        if (I.valid) { va[kk] = __builtin_nontemporal_load((const f32x4*)(I.wp + (size_t)(8 * kk) * I.Nsrc)); vb[kk] = __builtin_nontemporal_load((const f32x4*)(I.wp + (size_t)(8 * kk + 1) * I.Nsrc)); } }
}
__device__ __forceinline__ void cvt_process(const CvItem& I, f32x4 (&va)[8], f32x4 (&vb)[8], LAS unsigned* T, int lane) {
    const int c = lane & 15, kr2 = lane >> 4;
#pragma unroll
    for (int kk = 0; kk < 8; ++kk) {
        f32x4 a = va[kk], b = vb[kk];
        if (I.gp) { a *= I.gp[8 * kk]; b *= I.gp[8 * kk + 1]; }
        T[(4 * c + 0) * 33 + 4 * kk + kr2] = pk2(a[0], b[0]); T[(4 * c + 1) * 33 + 4 * kk + kr2] = pk2(a[1], b[1]);
        T[(4 * c + 2) * 33 + 4 * kk + kr2] = pk2(a[2], b[2]); T[(4 * c + 3) * 33 + 4 * kk + kr2] = pk2(a[3], b[3]);
    }
    LDS_WAIT();
    const int nl = lane >> 3, ch = lane & 7;
#pragma unroll
    for (int j = 0; j < 8; ++j) { const LAS unsigned* tp = T + (8 * j + nl) * 33 + 4 * ch;
        v4u o; o.x = tp[0]; o.y = tp[1]; o.z = tp[2]; o.w = tp[3];
        *(v4u*)(I.op + (size_t)(8 * j) * I.ldk) = o; }
    LDS_WAIT();
}
__device__ __forceinline__ void cvt_range(LAS unsigned char* lds, int it0, int it1, int gw, int NGW, const float* w_in, const float* w_oa, const float* w_ob, const float* w_out, const float* w_up, const float* w_dn, unsigned char* wsw, const float* ln1, const float* ln2) {
    const int lane = ltid() & 63, wave = ltid() >> 6;
    LAS unsigned* scr = (LAS unsigned*)(lds + wave * 8448);
    int it = it0 + gw;
    if (it >= it1) return;
    f32x4 va[8], vb[8], wa[8], wb[8];
    CvItem I = cvt_decode(it, lane, w_in, w_oa, w_ob, w_out, w_up, w_dn, wsw, ln1, ln2);
    cvt_load(I, va, vb);
#pragma unroll 1
    for (;;) {
        const bool m1 = it + NGW < it1; CvItem J = I;
        if (m1) { J = cvt_decode(it + NGW, lane, w_in, w_oa, w_ob, w_out, w_up, w_dn, wsw, ln1, ln2); cvt_load(J, wa, wb); }
        cvt_process(I, va, vb, scr, lane);
        if (!m1) break;
        const bool m2 = it + 2 * NGW < it1;
        if (m2) { I = cvt_decode(it + 2 * NGW, lane, w_in, w_oa, w_ob, w_out, w_up, w_dn, wsw, ln1, ln2); cvt_load(I, va, vb); }
        cvt_process(J, wa, wb, scr, lane);
        if (!m2) break;
        it += 2 * NGW;
    }
}
constexpr int CV_PER_CU = 48;
constexpr int CV_THRU_UP = CV_IN + 2 * CV_OA + CV_OUT + CV_UP;
struct CvPlan { int X, T1, T2; };
__device__ __forceinline__ CvPlan cvt_plan(int G) {
    const int u1 = (MPAD / 256) * (NIN / 256), u2 = (MPAD / 256) * (NUP / 256), idle1 = (u1 % G) ? G - u1 % G : 0, idle2 = (u2 % G) ? G - u2 % G : 0;
    CvPlan p; p.T1 = idle1 * CV_PER_CU; p.T2 = idle2 * CV_PER_CU; p.X = max(CV_IN, CV_THRU_UP - p.T1); return p;
}
__device__ __forceinline__ void phase_bias(const float* rel_bias, float* biasT) {
    for (int idx = lbid() * 512 + ltid(); idx < 2048; idx += gridDim.x * 512) {
        const int h = idx >> 7, d = idx & 127;
        int bk = d;
        if (d >= 16) { const float v = logf((float)d / 16.0f) / 2.0794415416798357f * 16.0f; bk = 16 + (int)v; if (bk > 31) bk = 31; }
        biasT[idx] = rel_bias[bk * 16 + h];
    }
}
__device__ __forceinline__ void phase_first(const float* xp, const float* xs, bf16* XB, float* RS) {
    const int tid_ = ltid(), lane = tid_ & 63, wave = tid_ >> 6;
    const int gw = lbid() * 8 + wave, NGW = gridDim.x * 8;
    for (int row = gw; row < MREAL; row += NGW) {
        const float* xr = row < MP ? xp + (size_t)row * D : xs + (size_t)(row - MP) * D;
        float ss = 0.f;
#pragma unroll
        for (int j = 0; j < 8; ++j) { const f32x4 v = ((const f32x4*)xr)[lane + 64 * j];
            v2u w; w.x = pk2(v.x, v.y); w.y = pk2(v.z, v.w); ((v2u*)(XB + (size_t)row * D))[lane + 64 * j] = w;
            const float r0 = bfl(w.x), r1 = bfh(w.x), r2 = bfl(w.y), r3 = bfh(w.y); ss += (r0 * r0 + r1 * r1) + (r2 * r2 + r3 * r3); }
        ss = wave_sum(ss);
        if (row < MP) { if (lane < 32) RS[(size_t)row * 32 + lane] = lane == 0 ? ss : 0.f; }
        else { float* sp = RS + (size_t)MP * 32 + (size_t)(row - MP) * 128; sp[lane] = lane == 0 ? ss : 0.f; sp[64 + lane] = 0.f; }
    }
}
constexpr int AT_KB = 0, AT_VT = 36864, AT_BT = 72704, AT_PW = 74752;
__device__ __forceinline__ void attn_prompt_unit(LAS unsigned char* lds, int u, int l, const bf16* PROJ, const float* lnq, const float* lnk, const float* sinks, const float* biasT, bf16* OA, float* outK, float* outV) {
    const int tid = ltid(), lane = tid & 63, wave = tid >> 6;
    const int kh = u & 3, nb = (u >> 2) & 31, b = u >> 7;
#pragma unroll
    for (int it = 0; it < 4; ++it) {
        const int idx = it * 512 + tid, j = idx >> 3, ch = idx & 7;
        const int tok = nb * 128 - 128 + j;
        v4u kw = {0u, 0u, 0u, 0u}, vw = {0u, 0u, 0u, 0u};
        if (tok >= 0) { const bf16* rp = PROJ + (size_t)(b * SEQ + tok) * NIN + kh * 64 + ch * 8; kw = *(const v4u*)(rp + C_KA); vw = *(const v4u*)(rp + C_VA); }
        float kf[8] = {bfl(kw.x), bfh(kw.x), bfl(kw.y), bfh(kw.y), bfl(kw.z), bfh(kw.z), bfl(kw.w), bfh(kw.w)};
        float ss = 0.f;
#pragma unroll
        for (int e = 0; e < 8; ++e) ss += kf[e] * kf[e];
        ss = red8_sum(ss);
        const float r = rsqrtf(ss * (1.0f / 64.0f) + EPS);
        const f32x4 g0 = *(const f32x4*)(lnk + l * 64 + ch * 8), g1 = *(const f32x4*)(lnk + l * 64 + ch * 8 + 4);
        kf[0] *= r * g0.x; kf[1] *= r * g0.y; kf[2] *= r * g0.z; kf[3] *= r * g0.w; kf[4] *= r * g1.x; kf[5] *= r * g1.y; kf[6] *= r * g1.z; kf[7] *= r * g1.w;
        v4u ko; ko.x = pk2(kf[0], kf[1]); ko.y = pk2(kf[2], kf[3]); ko.z = pk2(kf[4], kf[5]); ko.w = pk2(kf[6], kf[7]);
        *(LAS v4u*)(lds + AT_KB + j * 144 + ch * 16) = ko;
        const unsigned vv[4] = {vw.x, vw.y, vw.z, vw.w};
#pragma unroll
        for (int e = 0; e < 4; ++e) { *(LAS bf16*)(lds + AT_VT + ((ch * 8 + 2 * e) * 280 + j) * 2) = (bf16)(vv[e] & 0xffffu); *(LAS bf16*)(lds + AT_VT + ((ch * 8 + 2 * e + 1) * 280 + j) * 2) = (bf16)(vv[e] >> 16); }
        if (nb == 31 && j >= 128) {
            float* ok = outK + ((size_t)((l * 2 + b) * 128 + (j - 128))) * 256 + kh * 64 + ch * 8;
            *(f32x4*)ok = (f32x4){kf[0], kf[1], kf[2], kf[3]}; *(f32x4*)(ok + 4) = (f32x4){kf[4], kf[5], kf[6], kf[7]};
            float* ov = outV + ((size_t)((l * 2 + b) * 128 + (j - 128))) * 256 + kh * 64 + ch * 8;
            *(f32x4*)ov = (f32x4){bfl(vw.x), bfh(vw.x), bfl(vw.y), bfh(vw.y)}; *(f32x4*)(ov + 4) = (f32x4){bfl(vw.z), bfh(vw.z), bfl(vw.w), bfh(vw.w)};
        }
    }
    for (int idx = tid; idx < 64 * 24; idx += 512) *(LAS bf16*)(lds + AT_VT + ((idx / 24) * 280 + 256 + idx % 24) * 2) = (bf16)0;
    { const int g = tid >> 7, d = tid & 127; ((LAS float*)(lds + AT_BT))[tid] = biasT[(kh * 4 + g) * 128 + d]; }
    __syncthreads();
    const int g = wave >> 1, qh = wave & 1, hq = kh * 4 + g, lr = lane & 15, lq = lane >> 4;
    const float sink = sinks[l * 16 + hq];
    LAS bf16* Pw = (LAS bf16*)(lds + AT_PW + wave * 5376);
    const LAS float* BT = (const LAS float*)(lds + AT_BT) + g * 128;
    const bf16* qp0 = PROJ + (size_t)(b * SEQ + nb * 128 + 64 * qh + lr) * NIN + C_QA + hq * 64 + 8 * lq;
    v4u qn0 = *(const v4u*)qp0, qn1 = *(const v4u*)(qp0 + 32);
#pragma unroll 2
    for (int mt = 0; mt < 4; ++mt) {
        const int ibase = 64 * qh + 16 * mt, kt0 = 4 * qh + mt;
        const v4u q0 = qn0, q1 = qn1;
        if (mt < 3) { const bf16* qp = qp0 + (size_t)(16 * (mt + 1)) * NIN; qn0 = *(const v4u*)qp; qn1 = *(const v4u*)(qp + 32); }
        float qf[16] = {bfl(q0.x), bfh(q0.x), bfl(q0.y), bfh(q0.y), bfl(q0.z), bfh(q0.z), bfl(q0.w), bfh(q0.w), bfl(q1.x), bfh(q1.x), bfl(q1.y), bfh(q1.y), bfl(q1.z), bfh(q1.z), bfl(q1.w), bfh(q1.w)};
        float ss = 0.f;
#pragma unroll
        for (int e = 0; e < 16; ++e) ss += qf[e] * qf[e];
        ss = xrows_sum(ss);
        const float r = rsqrtf(ss * (1.0f / 64.0f) + EPS) * 0.125f;
        const float* gq = lnq + l * 64 + 8 * lq;
        const f32x4 ga = *(const f32x4*)gq, gb = *(const f32x4*)(gq + 4), gc = *(const f32x4*)(gq + 32), gd = *(const f32x4*)(gq + 36);
        v4u qa, qb;
        qa.x = pk2(qf[0] * r * ga.x, qf[1] * r * ga.y); qa.y = pk2(qf[2] * r * ga.z, qf[3] * r * ga.w); qa.z = pk2(qf[4] * r * gb.x, qf[5] * r * gb.y); qa.w = pk2(qf[6] * r * gb.z, qf[7] * r * gb.w);
        qb.x = pk2(qf[8] * r * gc.x, qf[9] * r * gc.y); qb.y = pk2(qf[10] * r * gc.z, qf[11] * r * gc.w); qb.z = pk2(qf[12] * r * gd.x, qf[13] * r * gd.y); qb.w = pk2(qf[14] * r * gd.z, qf[15] * r * gd.w);
        f32x4 s[9];
#pragma unroll
        for (int nt = 0; nt < 9; ++nt) {
            const LAS v4u* kp = (const LAS v4u*)(lds + AT_KB + ((kt0 + nt) * 16 + lr) * 144 + lq * 16);
            f32x4 a = {0.f, 0.f, 0.f, 0.f};
            a = __builtin_amdgcn_mfma_f32_16x16x32_bf16(as_frag(kp[0]), as_frag(qa), a, 0, 0, 0);
            a = __builtin_amdgcn_mfma_f32_16x16x32_bf16(as_frag(kp[4]), as_frag(qb), a, 0, 0, 0);
            s[nt] = a;
        }
        const int i = ibase + lr;
        float mx = -INFINITY;
#pragma unroll
        for (int nt = 0; nt < 9; ++nt)
#pragma unroll
            for (int rr = 0; rr < 4; ++rr) {
                const int j = (kt0 + nt) * 16 + 4 * lq + rr, dd = i + 128 - j;
                const bool ok = dd >= 0 && dd < 128 && (nb > 0 || j >= 128);
                const float sv = (s[nt][rr] + BT[dd & 127]) + (ok ? 0.f : -INFINITY);
                s[nt][rr] = sv; mx = fmaxf(mx, sv);
            }
        mx = fmaxf(xrows_max(mx), sink);
        float sum = 0.f;
#pragma unroll
        for (int nt = 0; nt < 9; ++nt)
#pragma unroll
            for (int rr = 0; rr < 4; ++rr) { const float p = __expf(s[nt][rr] - mx); s[nt][rr] = p; sum += p; }
        sum = xrows_sum(sum) + __expf(sink - mx);
        const float inv = __builtin_amdgcn_rcpf(sum);
        v2u pk[10];
#pragma unroll
        for (int nt = 0; nt < 9; ++nt) { pk[nt].x = pk2(s[nt][0], s[nt][1]); pk[nt].y = pk2(s[nt][2], s[nt][3]); }
        pk[9].x = 0u; pk[9].y = 0u;
        f32x4 o[4];
#pragma unroll
        for (int dt = 0; dt < 4; ++dt) o[dt] = (f32x4){0.f, 0.f, 0.f, 0.f};
#pragma unroll
        for (int ks = 0; ks < 5; ++ks) {
            v4u pf; pf.x = pk[2 * ks].x; pf.y = pk[2 * ks].y; pf.z = pk[2 * ks + 1].x; pf.w = pk[2 * ks + 1].y;
#pragma unroll
            for (int dt = 0; dt < 4; ++dt) {
                const LAS unsigned char* vb = lds + AT_VT + ((16 * dt + lr) * 280 + kt0 * 16 + 32 * ks + 4 * lq) * 2;
                const v2u lo = *(const LAS v2u*)vb, hi = *(const LAS v2u*)(vb + 32);
                v4u vf; vf.x = lo.x; vf.y = lo.y; vf.z = hi.x; vf.w = hi.y;
                o[dt] = __builtin_amdgcn_mfma_f32_16x16x32_bf16(as_frag(vf), as_frag(pf), o[dt], 0, 0, 0);
            }
        }
#pragma unroll
        for (int dt = 0; dt < 4; ++dt)
            { v2u w; w.x = pk2(o[dt][0] * inv, o[dt][1] * inv); w.y = pk2(o[dt][2] * inv, o[dt][3] * inv); *(v2u*)(OA + (size_t)(b * SEQ + nb * 128 + ibase + lr) * 2048 + hq * 64 + 16 * dt + 4 * lq) = w; }
    }
    __syncthreads();
}
constexpr int AS_K = 0, AS_V = 34320, AS_Q = 68112, AS_P = 70160;
__device__ __forceinline__ void attn_sample_unit(LAS unsigned char* lds, int u, int l, const bf16* PROJ, const float* cache_k, const float* cache_v, const float* lnq, const float* lnk, const float* sinks,
                                                 const float* biasT, bf16* OA, float* outK, float* outV) {
    const int tid = ltid(), lane = tid & 63, wave = tid >> 6;
    const int kh = u & 3, b = u >> 2;
    LAS float* KS = (LAS float*)(lds + AS_K); LAS float* VS = (LAS float*)(lds + AS_V);
    {
        const int d = tid & 63, jb = tid >> 6;
        const float* ckp = cache_k + ((size_t)((l * 32 + b) * 128)) * 256 + kh * 64 + d; const float* cvp = cache_v + ((size_t)((l * 32 + b) * 128)) * 256 + kh * 64 + d;
        float* okp = outK + ((size_t)((l * 32 + b) * 128)) * 256 + kh * 64 + d; float* ovp = outV + ((size_t)((l * 32 + b) * 128)) * 256 + kh * 64 + d;
        float kk[16], vv[16];
#pragma unroll
        for (int i = 0; i < 16; ++i) { const int j = jb + 8 * i; kk[i] = ckp[(size_t)j * 256]; vv[i] = cvp[(size_t)j * 256]; }
#pragma unroll
        for (int i = 0; i < 16; ++i) { const int j = jb + 8 * i; KS[j * 65 + d] = kk[i]; VS[j * 64 + d] = vv[i];
            if (j >= 4) { okp[(size_t)(j - 4) * 256] = kk[i]; ovp[(size_t)(j - 4) * 256] = vv[i]; } }
        if (jb < 4) {
            const int j = 128 + jb; const bf16* rp = PROJ + (size_t)(MP + b * 4 + jb) * NIN + kh * 64 + d; float kv = bf1(rp[C_KA]); const float v1 = bf1(rp[C_VA]);
            const float ss = wave_sum(kv * kv); kv = kv * rsqrtf(ss * (1.0f / 64.0f) + EPS) * lnk[l * 64 + d];
            KS[j * 65 + d] = kv; VS[j * 64 + d] = v1; okp[(size_t)(j - 4) * 256] = kv; ovp[(size_t)(j - 4) * 256] = v1; }
    }
    __syncthreads();
    LAS float* QS = (LAS float*)(lds + AS_Q) + wave * 64; LAS float* PS = (LAS float*)(lds + AS_P) + wave * 136;
#pragma unroll 1
    for (int s2 = 0; s2 < 2; ++s2) {
        const int rr = 2 * wave + s2, tt = rr & 3, g = rr >> 2, hq = kh * 4 + g;
        const size_t row = (size_t)(MP + b * 4 + tt);
        float q = bf1(PROJ[row * NIN + C_QA + hq * 64 + lane]);
        const float ss = wave_sum(q * q);
        q = q * rsqrtf(ss * (1.0f / 64.0f) + EPS) * lnq[l * 64 + lane] * 0.125f;
        QS[lane] = q; LDS_WAIT();
        const float sink = sinks[l * 16 + hq];
        float sc[3]; float m = sink;
#pragma unroll
        for (int c = 0; c < 3; ++c) {
            const int j = lane + 64 * c; float a = -INFINITY;
            if (j < 132) { const int dd = tt + 128 - j;
                if (dd >= 0 && dd < 128) { a = 0.f;
#pragma unroll 8
                    for (int d = 0; d < 64; ++d) a += QS[d] * KS[j * 65 + d];
                    a += biasT[hq * 128 + dd]; } }
            sc[c] = a; m = fmaxf(m, a);
        }
        m = wave_max(m);
        float sum = 0.f;
#pragma unroll
        for (int c = 0; c < 3; ++c) { const float p = __expf(sc[c] - m); sum += p; const int j = lane + 64 * c; if (j < 132) PS[j] = p; }
        sum = wave_sum(sum) + __expf(sink - m);
        LDS_WAIT();
        float o = 0.f;
#pragma unroll 4
        for (int j = 0; j < 132; ++j) o += PS[j] * VS[j * 64 + lane];
        OA[row * 2048 + hq * 64 + lane] = f2bf(o * __builtin_amdgcn_rcpf(sum));
        LDS_WAIT();
    }
    __syncthreads();
}
constexpr int GL_AL = 0, GL_KK = 8192, GL_QQ = 16384, GL_VV = 24576, GL_OB = 40960, GL_GS = 73728;
template <bool OUTC>
__device__ __forceinline__ void gla_unit(LAS unsigned char* lds, int l, int h, size_t rowbase, int ntok, const bf16* PROJ, const float* GK, const float* w_gk2, const float* b_gk, const float* ln_o,
                                         const float* Sin, float* Sout, float* DLout, bf16* OB) {
    const int tid = ltid(), lane = tid & 63, wave = tid >> 6;
    const int e = tid & 255, dh = tid >> 8, d = tid & 127, tg = tid >> 7;
    LAS float* AL = (LAS float*)(lds + GL_AL); LAS float* KK = (LAS float*)(lds + GL_KK); LAS float* QQ = (LAS float*)(lds + GL_QQ); LAS float* VV = (LAS float*)(lds + GL_VV);
    LAS float* OBF = (LAS float*)(lds + GL_OB); LAS float* GS = (LAS float*)(lds + GL_GS);
    float wg[16];
#pragma unroll
    for (int r = 0; r < 16; ++r) wg[r] = w_gk2[((size_t)l * 16 + r) * 512 + h * 128 + d];
    const float bg = b_gk[l * 512 + h * 128 + d];
    float S[64];
#pragma unroll
    for (int i = 0; i < 64; ++i) S[i] = OUTC ? Sin[(size_t)(dh * 64 + i) * 256 + e] : 0.f;
    float gacc = 0.f;
#pragma unroll 1
    for (int t0 = 0; t0 < ntok; t0 += 16) {
        const int nts = (ntok - t0) < 16 ? (ntok - t0) : 16;
#pragma unroll 1
        for (int i = 0; i < 4; ++i) {
            const int tt = tg * 4 + i;
            if (tt < nts) {
                const size_t row = rowbase + t0 + tt;
                const f32x4 k0 = *(const f32x4*)(GK + row * 16), k1 = *(const f32x4*)(GK + row * 16 + 4), k2 = *(const f32x4*)(GK + row * 16 + 8), k3 = *(const f32x4*)(GK + row * 16 + 12);
                float x = bg;
                x += k0.x * wg[0] + k0.y * wg[1] + k0.z * wg[2] + k0.w * wg[3]; x += k1.x * wg[4] + k1.y * wg[5] + k1.z * wg[6] + k1.w * wg[7];
                x += k2.x * wg[8] + k2.y * wg[9] + k2.z * wg[10] + k2.w * wg[11]; x += k3.x * wg[12] + k3.y * wg[13] + k3.z * wg[14] + k3.w * wg[15];
                const float gg = logsig(x) * (1.0f / 16.0f);
                gacc += gg;
                AL[tt * 128 + d] = __expf(gg);
                KK[tt * 128 + d] = bf1(PROJ[row * NIN + C_KB + h * 128 + d]);
                if (OUTC) QQ[tt * 128 + d] = bf1(PROJ[row * NIN + C_QB + h * 128 + d]) * 0.08838834764831845f;
            }
        }
        { const int tt = tid >> 5, e0 = (tid & 31) * 8;
          if (tt < nts) { const v4u w = *(const v4u*)(PROJ + (rowbase + t0 + tt) * NIN + C_VB + h * 256 + e0);
              *(LAS f32x4*)(VV + tt * 256 + e0) = (f32x4){bfl(w.x), bfh(w.x), bfl(w.y), bfh(w.y)}; *(LAS f32x4*)(VV + tt * 256 + e0 + 4) = (f32x4){bfl(w.z), bfh(w.z), bfl(w.w), bfh(w.w)}; } }
        __syncthreads();
#pragma unroll 1
        for (int tt = 0; tt < nts; ++tt) {
            const float ve = VV[tt * 256 + e];
            float o = 0.f;
#pragma unroll
            for (int q4 = 0; q4 < 16; ++q4) {
                const f32x4 a4 = *(const LAS f32x4*)(AL + tt * 128 + dh * 64 + 4 * q4), k4 = *(const LAS f32x4*)(KK + tt * 128 + dh * 64 + 4 * q4);
                S[4 * q4 + 0] = a4.x * S[4 * q4 + 0] + k4.x * ve; S[4 * q4 + 1] = a4.y * S[4 * q4 + 1] + k4.y * ve;
                S[4 * q4 + 2] = a4.z * S[4 * q4 + 2] + k4.z * ve; S[4 * q4 + 3] = a4.w * S[4 * q4 + 3] + k4.w * ve;
                if (OUTC) { const f32x4 c4 = *(const LAS f32x4*)(QQ + tt * 128 + dh * 64 + 4 * q4);
                    o += c4.x * S[4 * q4 + 0] + c4.y * S[4 * q4 + 1] + c4.z * S[4 * q4 + 2] + c4.w * S[4 * q4 + 3]; }
            }
            if (OUTC) OBF[(dh * 16 + tt) * 256 + e] = o;
        }
        __syncthreads();
        if (OUTC) {
#pragma unroll 1
            for (int s2 = 0; s2 < 2; ++s2) {
                const int tt = 2 * wave + s2;
                if (tt < nts) {
                    const size_t row = rowbase + t0 + tt;
                    const f32x4 oa = *(const LAS f32x4*)(OBF + tt * 256 + 4 * lane), ob = *(const LAS f32x4*)(OBF + (16 + tt) * 256 + 4 * lane);
                    const f32x4 o4 = oa + ob;
                    const float ss = wave_sum((o4.x * o4.x + o4.y * o4.y) + (o4.z * o4.z + o4.w * o4.w));
                    const float r = rsqrtf(ss * (1.0f / 256.0f) + EPS);
                    const f32x4 gn = *(const f32x4*)(ln_o + l * 256 + 4 * lane);
                    const v2u rw = *(const v2u*)(PROJ + row * NIN + C_RB + h * 256 + 4 * lane);
                    const float r0 = bfl(rw.x), r1 = bfh(rw.x), r2 = bfl(rw.y), r3 = bfh(rw.y);
                    v2u w; w.x = pk2(o4.x * r * gn.x * r0 * sigm(r0), o4.y * r * gn.y * r1 * sigm(r1)); w.y = pk2(o4.z * r * gn.z * r2 * sigm(r2), o4.w * r * gn.w * r3 * sigm(r3));
                    *(v2u*)(OB + row * 2048 + h * 256 + 4 * lane) = w;
                }
            }
            __syncthreads();
        }
    }
    if (Sout) {
#pragma unroll
        for (int i = 0; i < 64; ++i) Sout[(size_t)(dh * 64 + i) * 256 + e] = S[i];
    }
    if (!OUTC) {
        GS[tg * 128 + d] = gacc;
        __syncthreads();
        if (tid < 128) DLout[tid] = __expf(GS[tid] + GS[128 + tid] + GS[256 + tid] + GS[384 + tid]);
        __syncthreads();
    }
}
constexpr int GA_GK = 0, GA_TOT = 8192, GA_DL = 10240, GA_KT = 12288, GA_VT = 47104;
constexpr int GC_QL = 0, GC_KL = 34816, GC_VT = 69632;
__device__ __forceinline__ void gla_stage_vt(LAS unsigned char* vt, const bf16* vsrc  , int lane) {
#pragma unroll
    for (int it = 0; it < 8; ++it) {
        const int tok = it * 16 + (lane >> 2), ch = lane & 3;
        const v4u w = *(const v4u*)(vsrc + (size_t)tok * NIN + ch * 8);
        const unsigned ww[4] = {w.x, w.y, w.z, w.w};
#pragma unroll
        for (int e = 0; e < 4; ++e) { *(LAS bf16*)(vt + ((ch * 8 + 2 * e) * 136 + tok) * 2) = (bf16)(ww[e] & 0xffffu); *(LAS bf16*)(vt + ((ch * 8 + 2 * e + 1) * 136 + tok) * 2) = (bf16)(ww[e] >> 16); }
    }
}
__device__ __forceinline__ void gla_a_unit(LAS unsigned char* lds, int l, int h, size_t rowbase, const bf16* PROJ, const float* GK, const float* w_gk2, const float* b_gk, bf16* QT, bf16* KT, float* UT, float* DLout) {
    const int tid = ltid(), lane = tid & 63, wave = tid >> 6, d = tid & 127, seg = tid >> 7, lr = lane & 15, g = lane >> 4;
    LAS float* GKL = (LAS float*)(lds + GA_GK); LAS float* TOT = (LAS float*)(lds + GA_TOT); LAS float* DLL = (LAS float*)(lds + GA_DL);
    LAS unsigned char* KTL = lds + GA_KT; LAS unsigned char* VTW = lds + GA_VT + wave * 8704;
    *(LAS f32x4*)(GKL + tid * 4) = *(const f32x4*)(GK + rowbase * 16 + tid * 4);
    gla_stage_vt(VTW, PROJ + rowbase * NIN + C_VB + h * 256 + 32 * wave, lane);
    bf16 kraw[32], qraw[32];
#pragma unroll
    for (int ti = 0; ti < 32; ++ti) { const bf16* pp = PROJ + (rowbase + seg * 32 + ti) * NIN + h * 128 + d; kraw[ti] = pp[C_KB]; qraw[ti] = pp[C_QB]; }
    float wg[16];
#pragma unroll
    for (int r = 0; r < 16; ++r) wg[r] = w_gk2[((size_t)l * 16 + r) * 512 + h * 128 + d];
    const float bg = b_gk[l * 512 + h * 128 + d];
    __syncthreads();
    float gv[32]; float run = 0.f;
#pragma unroll
    for (int i = 0; i < 32; ++i) {
        const LAS f32x4* gp = (const LAS f32x4*)(GKL + (seg * 32 + i) * 16);
        const f32x4 k0 = gp[0], k1 = gp[1], k2 = gp[2], k3 = gp[3];
        float x = bg;
        x += k0.x * wg[0] + k0.y * wg[1] + k0.z * wg[2] + k0.w * wg[3]; x += k1.x * wg[4] + k1.y * wg[5] + k1.z * wg[6] + k1.w * wg[7];
        x += k2.x * wg[8] + k2.y * wg[9] + k2.z * wg[10] + k2.w * wg[11]; x += k3.x * wg[12] + k3.y * wg[13] + k3.z * wg[14] + k3.w * wg[15];
        run += logsig(x) * (1.0f / 16.0f); gv[i] = run;
    }
    TOT[seg * 128 + d] = run;
    __syncthreads();
    const float t0 = TOT[d], t1 = TOT[128 + d], t2 = TOT[256 + d], t3 = TOT[384 + d];
    const float off = seg == 0 ? 0.f : (seg == 1 ? t0 : (seg == 2 ? t0 + t1 : t0 + t1 + t2));
    if (seg == 0) { const float pd = __expf(((t0 + t1) + t2) + t3); DLL[d] = pd; DLout[d] = pd; }
    const size_t prow = rowbase + seg * 32;
#pragma unroll
    for (int i8 = 0; i8 < 4; ++i8) {
        float kt[8];
#pragma unroll
        for (int i = 0; i < 8; ++i) {
            const int ti = i8 * 8 + i; const float bb = off + gv[ti];
            const float kq = bf1(kraw[ti]), qq = bf1(qraw[ti]);
            kt[i] = kq * __expf(-bb);
            const float qt = qq * 0.08838834764831845f * __expf(bb);
            KT[(prow + ti) * 512 + h * 128 + d] = f2bf(kt[i]); QT[(prow + ti) * 512 + h * 128 + d] = f2bf(qt);
        }
        v4u w; w.x = pk2(kt[0], kt[1]); w.y = pk2(kt[2], kt[3]); w.z = pk2(kt[4], kt[5]); w.w = pk2(kt[6], kt[7]);
        *(LAS v4u*)(KTL + d * 272 + (seg * 32 + i8 * 8) * 2) = w;
    }
    __syncthreads();
    f32x4 acc[2][8];
#pragma unroll
    for (int mt = 0; mt < 2; ++mt)
#pragma unroll
        for (int nt = 0; nt < 8; ++nt) acc[mt][nt] = (f32x4){0.f, 0.f, 0.f, 0.f};
#pragma unroll
    for (int ks = 0; ks < 4; ++ks) {
        const v4u a0 = *(const LAS v4u*)(VTW + lr * 272 + (32 * ks + 8 * g) * 2), a1 = *(const LAS v4u*)(VTW + (16 + lr) * 272 + (32 * ks + 8 * g) * 2);
#pragma unroll
        for (int nt = 0; nt < 8; ++nt) {
            const v4u bf = *(const LAS v4u*)(KTL + (16 * nt + lr) * 272 + (32 * ks + 8 * g) * 2);
            acc[0][nt] = __builtin_amdgcn_mfma_f32_16x16x32_bf16(as_frag(bf), as_frag(a0), acc[0][nt], 0, 0, 0);
            acc[1][nt] = __builtin_amdgcn_mfma_f32_16x16x32_bf16(as_frag(bf), as_frag(a1), acc[1][nt], 0, 0, 0);
        }
    }
#pragma unroll
    for (int nt = 0; nt < 8; ++nt) { const f32x4 dl = *(const LAS f32x4*)(DLL + 16 * nt + 4 * g);
#pragma unroll
        for (int mt = 0; mt < 2; ++mt) *(f32x4*)(UT + (size_t)(32 * wave + 16 * mt + lr) * 128 + 16 * nt + 4 * g) = acc[mt][nt] * dl; }
    __syncthreads();
}
__device__ __forceinline__ void gla_scan2(int l, const float* GU, const float* GDL, bf16* GS, float* outG) {
    for (int blk = lbid(); blk < 8 * 256 * 64 / 512; blk += gridDim.x) {
        const int bh = blk >> 5; const unsigned rem = (unsigned)((blk & 31) * 512 + ltid()), e = rem >> 6, d2 = (rem & 63u) * 2u;
        const unsigned vo = e * 128u + d2;
        const float* gu = GU + (size_t)bh * NCH * 32768; const float* gd = GDL + (size_t)bh * NCH * 128; bf16* gs = GS + (size_t)bh * NCH * 32768;
        float s0 = 0.f, s1 = 0.f;
        float2 uu[NCH], dl[NCH];
#pragma unroll
        for (int i = 0; i < NCH; ++i) { uu[i] = *(const float2*)(gu + (size_t)i * 32768 + vo); dl[i] = *(const float2*)(gd + i * 128 + d2); }
#pragma unroll
        for (int i = 0; i < NCH; ++i) { *(unsigned*)(gs + (size_t)i * 32768 + vo) = pk2(s0, s1); s0 = dl[i].x * s0 + uu[i].x; s1 = dl[i].y * s1 + uu[i].y; }
        float* op = outG + ((size_t)(l * 8 + bh)) * 32768 + (size_t)d2 * 256 + e;
        op[0] = s0; op[256] = s1;
    }
}
__device__ __forceinline__ void gla_c_unit(LAS unsigned char* lds, int l, int h, size_t rowbase, const bf16* PROJ, const bf16* QT, const bf16* KT, const bf16* ST, const float* ln_o, bf16* OB) {
    const int tid = ltid(), lane = tid & 63, wave = tid >> 6, lr = lane & 15, g = lane >> 4;
    LAS unsigned char* QL = lds + GC_QL; LAS unsigned char* KL = lds + GC_KL; LAS unsigned char* VTW = lds + GC_VT + wave * 8704;
#pragma unroll
    for (int it = 0; it < 4; ++it) { const int idx = it * 512 + tid, row = idx >> 4, ch = idx & 15;
        *(LAS v4u*)(QL + row * 272 + ch * 16) = *(const v4u*)(QT + (rowbase + row) * 512 + h * 128 + ch * 8);
        *(LAS v4u*)(KL + row * 272 + ch * 16) = *(const v4u*)(KT + (rowbase + row) * 512 + h * 128 + ch * 8); }
    gla_stage_vt(VTW, PROJ + rowbase * NIN + C_VB + h * 256 + 32 * wave, lane);
    v4u sA[2][4];
#pragma unroll
    for (int mt = 0; mt < 2; ++mt)
#pragma unroll
        for (int ks = 0; ks < 4; ++ks) sA[mt][ks] = *(const v4u*)(ST + (size_t)(32 * wave + 16 * mt + lr) * 128 + 32 * ks + 8 * g);
    __syncthreads();
    f32x4 acc[2][8];
#pragma unroll
    for (int mi = 0; mi < 8; ++mi) {
        v4u qB[4];
#pragma unroll
        for (int ks = 0; ks < 4; ++ks) qB[ks] = *(const LAS v4u*)(QL + (16 * mi + lr) * 272 + (32 * ks + 8 * g) * 2);
        v2u pk[8];
#pragma unroll
        for (int nj = 0; nj < 8; ++nj) {
            if (nj <= mi) {
                f32x4 pt = {0.f, 0.f, 0.f, 0.f};
#pragma unroll
                for (int ks = 0; ks < 4; ++ks) { const v4u kA = *(const LAS v4u*)(KL + (16 * nj + lr) * 272 + (32 * ks + 8 * g) * 2);
                    pt = __builtin_amdgcn_mfma_f32_16x16x32_bf16(as_frag(kA), as_frag(qB[ks]), pt, 0, 0, 0); }
                if (nj == mi) {
#pragma unroll
                    for (int r = 0; r < 4; ++r) pt[r] = (4 * g + r <= lr) ? pt[r] : 0.f;
                }
                pk[nj].x = pk2(pt[0], pt[1]); pk[nj].y = pk2(pt[2], pt[3]);
            } else { pk[nj].x = 0u; pk[nj].y = 0u; }
        }
        f32x4 a0 = {0.f, 0.f, 0.f, 0.f}, a1 = {0.f, 0.f, 0.f, 0.f};
#pragma unroll
        for (int kj = 0; kj < 4; ++kj) {
            if (2 * kj <= mi) {
                v4u bfr; bfr.x = pk[2 * kj].x; bfr.y = pk[2 * kj].y; bfr.z = pk[2 * kj + 1].x; bfr.w = pk[2 * kj + 1].y;
                const v2u lo0 = *(const LAS v2u*)(VTW + lr * 272 + (32 * kj + 4 * g) * 2), hi0 = *(const LAS v2u*)(VTW + lr * 272 + (32 * kj + 16 + 4 * g) * 2);
                const v2u lo1 = *(const LAS v2u*)(VTW + (16 + lr) * 272 + (32 * kj + 4 * g) * 2), hi1 = *(const LAS v2u*)(VTW + (16 + lr) * 272 + (32 * kj + 16 + 4 * g) * 2);
                v4u f0; f0.x = lo0.x; f0.y = lo0.y; f0.z = hi0.x; f0.w = hi0.y;
                v4u f1; f1.x = lo1.x; f1.y = lo1.y; f1.z = hi1.x; f1.w = hi1.y;
                a0 = __builtin_amdgcn_mfma_f32_16x16x32_bf16(as_frag(f0), as_frag(bfr), a0, 0, 0, 0);
                a1 = __builtin_amdgcn_mfma_f32_16x16x32_bf16(as_frag(f1), as_frag(bfr), a1, 0, 0, 0);
            }
        }
#pragma unroll
        for (int ks = 0; ks < 4; ++ks) {
            a0 = __builtin_amdgcn_mfma_f32_16x16x32_bf16(as_frag(sA[0][ks]), as_frag(qB[ks]), a0, 0, 0, 0);
            a1 = __builtin_amdgcn_mfma_f32_16x16x32_bf16(as_frag(sA[1][ks]), as_frag(qB[ks]), a1, 0, 0, 0);
        }
        acc[0][mi] = a0; acc[1][mi] = a1;
        __builtin_amdgcn_sched_barrier(0);
    }
    v2u rbv[16];
#pragma unroll
    for (int t = 0; t < 16; ++t) rbv[t] = *(const v2u*)(PROJ + (rowbase + wave * 16 + t) * NIN + C_RB + h * 256 + 4 * lane);
    __syncthreads();
    LAS float* OL = (LAS float*)lds;
#pragma unroll
    for (int mi = 0; mi < 8; ++mi)
#pragma unroll
        for (int mt = 0; mt < 2; ++mt) *(LAS f32x4*)(OL + (16 * mi + lr) * 260 + 32 * wave + 16 * mt + 4 * g) = acc[mt][mi];
    __syncthreads();
    const f32x4 gn = *(const f32x4*)(ln_o + l * 256 + 4 * lane);
#pragma unroll
    for (int t = 0; t < 16; ++t) {
        const int tok = wave * 16 + t; const size_t row = rowbase + tok;
        const f32x4 o4 = *(const LAS f32x4*)(OL + tok * 260 + 4 * lane);
        const float ss = wave_sum((o4.x * o4.x + o4.y * o4.y) + (o4.z * o4.z + o4.w * o4.w));
        const float r = rsqrtf(ss * (1.0f / 256.0f) + EPS);
        const v2u rw = rbv[t];
        const float r0 = bfl(rw.x), r1 = bfh(rw.x), r2 = bfl(rw.y), r3 = bfh(rw.y);
        v2u w; w.x = pk2(o4.x * r * gn.x * r0 * sigm(r0), o4.y * r * gn.y * r1 * sigm(r1)); w.y = pk2(o4.z * r * gn.z * r2 * sigm(r2), o4.w * r * gn.w * r3 * sigm(r3));
        *(v2u*)(OB + row * 2048 + h * 256 + 4 * lane) = w;
    }
    __syncthreads();
}
__device__ __forceinline__ void gla_scan(int l, float* GU, const float* GDL, float* outG) {
    for (int idx = lbid() * 512 + ltid(); idx < 8 * 32768; idx += gridDim.x * 512) {
        const int bh = idx >> 15, de = idx & 32767, d = de >> 8;
        float S = 0.f;
#pragma unroll 1
        for (int c0 = 0; c0 < NCH; c0 += 8) {
            float uu[8], dl[8];
#pragma unroll
            for (int i = 0; i < 8; ++i) { uu[i] = GU[((size_t)(bh * NCH + c0 + i)) * 32768 + de]; dl[i] = GDL[(bh * NCH + c0 + i) * 128 + d]; }
#pragma unroll
            for (int i = 0; i < 8; ++i) { GU[((size_t)(bh * NCH + c0 + i)) * 32768 + de] = S; S = dl[i] * S + uu[i]; }
        }
        outG[((size_t)(l * 8 + bh)) * 32768 + de] = S;
    }
}
__device__ __forceinline__ float gelu_tanh(float x) { const float z = 1.5957691216057308f * (x + 0.044715f * x * x * x); return x * __builtin_amdgcn_rcpf(1.0f + __expf(-z)); }
__device__ __forceinline__ void phase_conv(int l, const bf16* U, const float* state_conv, const float* w_conv, const float* b_conv, bf16* ACT, float* outCP, float* outCS, int seg0, int nseg) {
    constexpr int NCG = DFF / 8;
    const int per = (nseg * NCG + (int)gridDim.x - 1) / (int)gridDim.x;
    for (int k = ltid() - 256; k >= 0 && k < per; k += 256) {
        const int idx = lbid() * per + k; if (idx >= nseg * NCG) break;
        const int seg = seg0 + idx / NCG, cg = idx % NCG, j0 = cg * 8;
        float wv[3][8], wgt[3][8], bv[8], bgt[8];
#pragma unroll
        for (int i = 0; i < 3; ++i) { const float* wp = w_conv + ((size_t)l * 3 + i) * NUP + j0;
            const f32x4 a = *(const f32x4*)wp, b4 = *(const f32x4*)(wp + 4), c = *(const f32x4*)(wp + DFF), d4 = *(const f32x4*)(wp + DFF + 4);
            wv[i][0] = a.x; wv[i][1] = a.y; wv[i][2] = a.z; wv[i][3] = a.w; wv[i][4] = b4.x; wv[i][5] = b4.y; wv[i][6] = b4.z; wv[i][7] = b4.w;
            wgt[i][0] = c.x; wgt[i][1] = c.y; wgt[i][2] = c.z; wgt[i][3] = c.w; wgt[i][4] = d4.x; wgt[i][5] = d4.y; wgt[i][6] = d4.z; wgt[i][7] = d4.w; }
        { const float* bp = b_conv + (size_t)l * NUP + j0; const f32x4 a = *(const f32x4*)bp, b4 = *(const f32x4*)(bp + 4), c = *(const f32x4*)(bp + DFF), d4 = *(const f32x4*)(bp + DFF + 4);
            bv[0] = a.x; bv[1] = a.y; bv[2] = a.z; bv[3] = a.w; bv[4] = b4.x; bv[5] = b4.y; bv[6] = b4.z; bv[7] = b4.w;
            bgt[0] = c.x; bgt[1] = c.y; bgt[2] = c.z; bgt[3] = c.w; bgt[4] = d4.x; bgt[5] = d4.y; bgt[6] = d4.z; bgt[7] = d4.w; }
        float p2v[8], p1v[8], p2g[8], p1g[8];
        size_t rowb; int ntok; float* outp = nullptr; int out_t0 = 0;
        if (seg < 256) {
            const int b = seg >> 7, t0 = (seg & 127) * 32; rowb = (size_t)b * SEQ + t0; ntok = 32;
            if (t0 == 0) {
#pragma unroll
                for (int e = 0; e < 8; ++e) { p2v[e] = 0.f; p1v[e] = 0.f; p2g[e] = 0.f; p1g[e] = 0.f; }
            } else {
                const v4u a = *(const v4u*)(U + (rowb - 2) * NUP + j0), b4 = *(const v4u*)(U + (rowb - 2) * NUP + DFF + j0), c = *(const v4u*)(U + (rowb - 1) * NUP + j0), d4 = *(const v4u*)(U + (rowb - 1) * NUP + DFF + j0);
                p2v[0] = bfl(a.x); p2v[1] = bfh(a.x); p2v[2] = bfl(a.y); p2v[3] = bfh(a.y); p2v[4] = bfl(a.z); p2v[5] = bfh(a.z); p2v[6] = bfl(a.w); p2v[7] = bfh(a.w);
                p2g[0] = bfl(b4.x); p2g[1] = bfh(b4.x); p2g[2] = bfl(b4.y); p2g[3] = bfh(b4.y); p2g[4] = bfl(b4.z); p2g[5] = bfh(b4.z); p2g[6] = bfl(b4.w); p2g[7] = bfh(b4.w);
                p1v[0] = bfl(c.x); p1v[1] = bfh(c.x); p1v[2] = bfl(c.y); p1v[3] = bfh(c.y); p1v[4] = bfl(c.z); p1v[5] = bfh(c.z); p1v[6] = bfl(c.w); p1v[7] = bfh(c.w);
                p1g[0] = bfl(d4.x); p1g[1] = bfh(d4.x); p1g[2] = bfl(d4.y); p1g[3] = bfh(d4.y); p1g[4] = bfl(d4.z); p1g[5] = bfh(d4.z); p1g[6] = bfl(d4.w); p1g[7] = bfh(d4.w);
            }
            if (t0 == SEQ - 32) { outp = outCP + ((size_t)(l * 2 + b) * 2) * NUP + j0; out_t0 = 30; }
        } else {
            const int b = seg - 256; rowb = (size_t)MP + b * 4; ntok = 4;
            const float* sp = state_conv + ((size_t)(l * 32 + b) * 2) * NUP + j0;
#pragma unroll
            for (int e = 0; e < 8; ++e) { p2v[e] = sp[e]; p2g[e] = sp[DFF + e]; p1v[e] = sp[NUP + e]; p1g[e] = sp[NUP + DFF + e]; }
            outp = outCS + ((size_t)(l * 32 + b) * 2) * NUP + j0; out_t0 = 2;
        }
#pragma unroll 1
        for (int t0 = 0; t0 < ntok; t0 += 4) {
            v4u la[4], lb[4];
#pragma unroll
            for (int i = 0; i < 4; ++i) { la[i] = *(const v4u*)(U + (rowb + t0 + i) * NUP + j0); lb[i] = *(const v4u*)(U + (rowb + t0 + i) * NUP + DFF + j0); }
#pragma unroll
            for (int i = 0; i < 4; ++i) {
                const int t = t0 + i; const v4u a = la[i], b4 = lb[i];
                const float cv[8] = {bfl(a.x), bfh(a.x), bfl(a.y), bfh(a.y), bfl(a.z), bfh(a.z), bfl(a.w), bfh(a.w)};
                const float cg2[8] = {bfl(b4.x), bfh(b4.x), bfl(b4.y), bfh(b4.y), bfl(b4.z), bfh(b4.z), bfl(b4.w), bfh(b4.w)};
                float act[8];
#pragma unroll
                for (int e = 0; e < 8; ++e) {
                    const float vc = wv[0][e] * p2v[e] + wv[1][e] * p1v[e] + wv[2][e] * cv[e] + bv[e];
                    const float gc = wgt[0][e] * p2g[e] + wgt[1][e] * p1g[e] + wgt[2][e] * cg2[e] + bgt[e];
                    act[e] = gelu_tanh(gc) * vc;
                    p2v[e] = p1v[e]; p1v[e] = cv[e]; p2g[e] = p1g[e]; p1g[e] = cg2[e];
                }
                v4u w; w.x = pk2(act[0], act[1]); w.y = pk2(act[2], act[3]); w.z = pk2(act[4], act[5]); w.w = pk2(act[6], act[7]);
                *(v4u*)(ACT + (rowb + t) * DFF + j0) = w;
                if (outp && t >= out_t0) { float* op = outp + (size_t)(t - out_t0) * NUP;
                    *(f32x4*)op = (f32x4){cv[0], cv[1], cv[2], cv[3]}; *(f32x4*)(op + 4) = (f32x4){cv[4], cv[5], cv[6], cv[7]};
                    *(f32x4*)(op + DFF) = (f32x4){cg2[0], cg2[1], cg2[2], cg2[3]}; *(f32x4*)(op + DFF + 4) = (f32x4){cg2[4], cg2[5], cg2[6], cg2[7]}; }
            }
        }
    }
}
__device__ __forceinline__ void phase_convfix(int l, const float* RAWB, const float* w_conv, const float* b_conv, bf16* ACT, float* outCP) {
    for (int grp = lbid() + (int)gridDim.x * (ltid() >> 4); grp < 32 * 44 && ltid() < 96; grp += (int)gridDim.x * 6) {
        const int idx = grp * 16 + (ltid() & 15);
        const int cg = idx & 15, pn = (idx >> 4) % 44, pm = idx / (16 * 44), c0 = 8 * cg, j0 = 128 * pn + c0;
        const float* rb = RAWB + ((size_t)(pm * 44 + pn) * 4) * 256;
        float r0v[8], r1v[8], r0g[8], r1g[8], p2v[8], p1v[8], p2g[8], p1g[8];
#pragma unroll
        for (int e = 0; e < 8; ++e) { r0v[e] = rb[c0 + e]; r0g[e] = rb[128 + c0 + e]; r1v[e] = rb[256 + c0 + e]; r1g[e] = rb[256 + 128 + c0 + e]; }
        if ((pm & 15) == 0) {
#pragma unroll
            for (int e = 0; e < 8; ++e) { p2v[e] = 0.f; p1v[e] = 0.f; p2g[e] = 0.f; p1g[e] = 0.f; }
        } else { const float* pb = RAWB + ((size_t)((pm - 1) * 44 + pn) * 4 + 2) * 256;
#pragma unroll
            for (int e = 0; e < 8; ++e) { p2v[e] = pb[c0 + e]; p2g[e] = pb[128 + c0 + e]; p1v[e] = pb[256 + c0 + e]; p1g[e] = pb[256 + 128 + c0 + e]; }
        }
        float a0[8], a1[8];
#pragma unroll
        for (int e = 0; e < 8; ++e) {
            const float w0v = w_conv[((size_t)l * 3 + 0) * NUP + j0 + e], w1v = w_conv[((size_t)l * 3 + 1) * NUP + j0 + e], w2v = w_conv[((size_t)l * 3 + 2) * NUP + j0 + e], bv = b_conv[(size_t)l * NUP + j0 + e];
            const float w0g = w_conv[((size_t)l * 3 + 0) * NUP + DFF + j0 + e], w1g = w_conv[((size_t)l * 3 + 1) * NUP + DFF + j0 + e], w2g = w_conv[((size_t)l * 3 + 2) * NUP + DFF + j0 + e], bg = b_conv[(size_t)l * NUP + DFF + j0 + e];
            a0[e] = gelu_tanh(w0g * p2g[e] + w1g * p1g[e] + w2g * r0g[e] + bg) * (w0v * p2v[e] + w1v * p1v[e] + w2v * r0v[e] + bv);
            a1[e] = gelu_tanh(w0g * p1g[e] + w1g * r0g[e] + w2g * r1g[e] + bg) * (w0v * p1v[e] + w1v * r0v[e] + w2v * r1v[e] + bv);
        }
        v4u w; w.x = pk2(a0[0], a0[1]); w.y = pk2(a0[2], a0[3]); w.z = pk2(a0[4], a0[5]); w.w = pk2(a0[6], a0[7]);
        *(v4u*)(ACT + (size_t)(256 * pm) * DFF + j0) = w;
        w.x = pk2(a1[0], a1[1]); w.y = pk2(a1[2], a1[3]); w.z = pk2(a1[4], a1[5]); w.w = pk2(a1[6], a1[7]);
        *(v4u*)(ACT + (size_t)(256 * pm + 1) * DFF + j0) = w;
        if ((pm & 15) == 15) { const int b = pm >> 4; float* op = outCP + ((size_t)(l * 2 + b) * 2) * NUP + j0;
#pragma unroll
            for (int e = 0; e < 8; ++e) { op[e] = rb[2 * 256 + c0 + e]; op[DFF + e] = rb[2 * 256 + 128 + c0 + e]; op[NUP + e] = rb[3 * 256 + c0 + e]; op[NUP + DFF + e] = rb[3 * 256 + 128 + c0 + e]; } }
    }
}
constexpr int SK_PITCH = 528, SK_BUF = 64 * SK_PITCH;
#define SK_LOAD(s_) do { _Pragma("unroll") for (int j = 0; j < 4; ++j) st[j] = *(const v4u*)(A + (size_t)(rb + 8 * j + (gl >> 5)) * lda + kh * KH + (s_) * 256 + 8 * (gl & 31)); \
                         _Pragma("unroll") for (int j = 0; j < 4; ++j) st[4 + j] = *(const v4u*)(Wt + (size_t)(cb + 8 * j + (gl >> 5)) * ldb + kh * KH + (s_) * 256 + 8 * (gl & 31)); } while (0)
#define SK_STORE(b_) do { _Pragma("unroll") for (int j = 0; j < 8; ++j) *(LAS v4u*)(lds + ((b_) * 2 + kh) * SK_BUF + (8 * j + (gl >> 5)) * SK_PITCH + (gl & 31) * 16) = st[j]; } while (0)
__device__ __forceinline__ f32x4 skinny_acc(LAS unsigned char* lds, const bf16* A, int lda, const bf16* Wt, int ldb, int K, int rb, int cb, f32x4 acc) {
    const int tid = ltid(), lane = tid & 63, wave = tid >> 6, lr = lane & 15, g = lane >> 4, mt = wave & 1, nt = (wave >> 1) & 1, kh = wave >> 2, gl = tid & 255;
    const int KH = K >> 1, ns = KH >> 8;
    v4u st[8];
    SK_LOAD(0); SK_STORE(0);
    __syncthreads();
#pragma unroll 1
    for (int s2 = 0; s2 < ns; ++s2) {
        const bool more = s2 + 1 < ns;
        if (more) SK_LOAD(s2 + 1);
        const LAS unsigned char* ab = lds + ((s2 & 1) * 2 + kh) * SK_BUF + (16 * mt + lr) * SK_PITCH + g * 16;
        const LAS unsigned char* bb = lds + ((s2 & 1) * 2 + kh) * SK_BUF + (32 + 16 * nt + lr) * SK_PITCH + g * 16;
#pragma unroll
        for (int i = 0; i < 8; ++i) acc = __builtin_amdgcn_mfma_f32_16x16x32_bf16(as_frag(*(const LAS v4u*)(ab + 64 * i)), as_frag(*(const LAS v4u*)(bb + 64 * i)), acc, 0, 0, 0);
        if (more) SK_STORE((s2 + 1) & 1);
        __syncthreads();
    }
    return acc;
}
#undef SK_LOAD
#undef SK_STORE
__device__ __forceinline__ f32x4 skinny_reduce(LAS unsigned char* lds, f32x4 a, int kh, int ti, int lane) {
    LAS f32x4* R = (LAS f32x4*)lds;
    if (kh == 1) R[ti * 64 + lane] = a;
    __syncthreads();
    if (kh == 0) a = a + R[ti * 64 + lane];
    __syncthreads();
    return a;
}
__device__ __forceinline__ void skinny_mix(LAS unsigned char* lds, int item, const bf16* OA, const bf16* WOA, const bf16* OB, const bf16* WOB, const bf16* PROJ, bf16* MIX) {
    const int tid = ltid(), lane = tid & 63, wave = tid >> 6, lr = lane & 15, g = lane >> 4, mt = wave & 1, nt = (wave >> 1) & 1, kh = wave >> 2, rb = 32 * (item & 3), cb = 32 * (item >> 2);
    f32x4 a1 = {0.f, 0.f, 0.f, 0.f}, a2 = {0.f, 0.f, 0.f, 0.f};
    a1 = skinny_acc(lds, OA + (size_t)MP * 2048, 2048, WOA, 2048, 1024, rb, cb, a1);
    a2 = skinny_acc(lds, OB + (size_t)MP * 2048, 2048, WOB, 2048, 1024, rb, cb, a2);
    a1 = skinny_reduce(lds, a1, kh, wave & 3, lane); a2 = skinny_reduce(lds, a2, kh, wave & 3, lane);
    if (kh == 0) { const int colb = cb + 16 * nt + lr;
#pragma unroll
        for (int r = 0; r < 4; ++r) { const size_t row = (size_t)MP + rb + 16 * mt + 4 * g + r;
            const float ga = bf1(PROJ[row * NIN + C_GA + colb]), gb = bf1(PROJ[row * NIN + C_GB + colb]);
            MIX[row * D + colb] = f2bf(sigm(ga) * a1[r] + sigm(gb) * a2[r]); }
    }
}
__device__ __forceinline__ void skinny_res(LAS unsigned char* lds, int item, const bf16* A, const bf16* Wt, int K, bf16* XB, float* Yf, float* SS) {
    const int tid = ltid(), lane = tid & 63, wave = tid >> 6, lr = lane & 15, g = lane >> 4, mt = wave & 1, nt = (wave >> 1) & 1, kh = wave >> 2, rb = 32 * (item & 3), cb = 32 * (item >> 2);
    f32x4 a1 = {0.f, 0.f, 0.f, 0.f};
    a1 = skinny_acc(lds, A + (size_t)MP * K, K, Wt, K, K, rb, cb, a1);
    a1 = skinny_reduce(lds, a1, kh, wave & 3, lane);
    if (kh == 0) { const int colb = cb + 16 * nt + lr;
#pragma unroll
        for (int r = 0; r < 4; ++r) { const size_t row = (size_t)MP + rb + 16 * mt + 4 * g + r, o = row * D + colb; const float y = bf1(XB[o]) + a1[r];
            if (Yf) Yf[o] = y;
            else { const bf16 yb = f2bf(y); XB[o] = yb; const float yr = bf1(yb); float ss = red16_sum(yr * yr);
                if (lr == 0) SS[(size_t)MP * 32 + (row - MP) * 128 + (cb >> 4) + nt] = ss; } }
    }
}
__device__ __forceinline__ void phase_rstd(const float* SS, float* RS) {
    for (int row = lbid() * 512 + ltid(); row < MREAL; row += gridDim.x * 512) {
        f32x4 t = {0.f, 0.f, 0.f, 0.f};
        if (row < MP) { const f32x4* sp = (const f32x4*)(SS + (size_t)row * 32);
#pragma unroll
            for (int i = 0; i < 8; ++i) t += sp[i]; }
        else { const f32x4* sp = (const f32x4*)(SS + (size_t)MP * 32 + (size_t)(row - MP) * 128);
#pragma unroll 8
            for (int i = 0; i < 32; ++i) t += sp[i]; }
        RS[row] = rsqrtf(((t[0] + t[1]) + (t[2] + t[3])) * (1.0f / D) + EPS);
    }
}
struct Args { const float* in[23]; float* out; unsigned char* ws; int l_lo, l_hi, ph_lo, ph_hi; };
typedef const __attribute__((address_space(4))) Args* ArgsP;
__device__ __forceinline__ ArgsP largs() { ArgsP p = (ArgsP)__builtin_amdgcn_kernarg_segment_ptr(); asm volatile("" : "+s"(p)); return p; }
enum { I_XP = 0, I_XS, I_CK, I_CV, I_SG, I_SC, I_RB, I_LN1, I_WIN, I_LNQ, I_LNK, I_SINK, I_WGK2, I_BGK, I_LNO, I_WOA, I_WOB, I_WOUT, I_LN2, I_WUP, I_WCONV, I_BCONV, I_WDN };
__global__ void __launch_bounds__(512, 2) hyb_fwd(Args a) {
    extern __shared__ __attribute__((aligned(16))) unsigned char lds_raw[];
    LAS unsigned char* lds = (LAS unsigned char*)lds_raw;
    volatile LAS unsigned* MISC = (volatile LAS unsigned*)(lds + MISC_OFF);
    if (threadIdx.x < 32) MISC[threadIdx.x] = 0u;
    __syncthreads();
    const bool fused = (a.ph_hi - a.ph_lo > 1) || (a.l_hi - a.l_lo > 1);
    XcdBarrier bar; bar.bar = (unsigned*)(a.ws + WS_CTL) + CW_BAR; bar.x = 0; bar.st = MISC + 8;
    if (fused) bar = xcd_barrier_post((unsigned*)(a.ws + WS_CTL) + CW_BAR, MISC + 8);
#ifndef PHMASK
#define PHMASK 0x7ff
#endif
#define IN(k) (((PHMASK >> (k)) & 1) && a.ph_lo <= (k) && (k) < a.ph_hi)
#ifndef REPMASK
#define REPMASK 0
#endif
#define REP(k) (((REPMASK >> (k)) & 1) ? 2 : 1)
#define SEAM(k) do { if (fused && !((k) == NPH - 1 && l == a.l_hi - 1)) xcd_barrier(bar); } while (0)
#define WSP(off, T) ((T*)(A->ws + (off)))
#define WSW(off) ((bf16*)(A->ws + (off) + ((l & 1) ? (WS_W2 - WS_WIN) : (size_t)0)))
#pragma unroll 1
    for (int l = a.l_lo; l < a.l_hi; ++l) {
        if (IN(0) && l == 0) for (int rep_ = 0; rep_ < REP(0); ++rep_) {
            ArgsP A = largs();
            { const int G = gridDim.x; const CvPlan cp = cvt_plan(G);
              cvt_range(lds, 0, min(cp.X, DEPTH * CV_NIT), lbid() * 8 + (ltid() >> 6), G * 8, A->in[I_WIN], A->in[I_WOA], A->in[I_WOB], A->in[I_WOUT], A->in[I_WUP], A->in[I_WDN], A->ws, A->in[I_LN1], A->in[I_LN2]); }
            if (l == 0) phase_bias(A->in[I_RB], WSP(WS_BIAS, float));
            if (l == 0) phase_first(A->in[I_XP], A->in[I_XS], WSP(WS_H, bf16), WSP(WS_SS2, float));
            SEAM(0);
        }
        if (IN(1)) for (int rep_ = 0; rep_ < REP(1); ++rep_) {
            ArgsP A = largs();
            pg8::Gemm g{WSP(WS_H, bf16), WSW(WS_WIN), MPAD, NIN, D}; pg8::StaticOrder S; S.init(MPAD, NIN, gridDim.x, lbid());
            pg8::EpiBf E{WSP(WS_GT, pg8::u32x4), C_GA / 256, WSP(WS_PROJ, bf16), NIN, WSP(WS_GK, float), C_GK / 256, WSP(WS_SS2, float), (PG8_LAS float*)(lds + RING_BYTES) + 3072};
            pg8::gemm_phase<pg8::EpiBf, pg8::StaticOrder, true, true>(lds, g, S, E);
            { const int G = gridDim.x, u1 = (MPAD / 256) * (NIN / 256), first = u1 % G, idle1 = first ? G - first : 0; const CvPlan cp = cvt_plan(G);
              if (idle1 && lbid() >= first) cvt_range(lds, min(l * CV_NIT + cp.X, DEPTH * CV_NIT), min(l * CV_NIT + cp.X + cp.T1, DEPTH * CV_NIT), (lbid() - first) * 8 + (ltid() >> 6), idle1 * 8,
                                                                       A->in[I_WIN], A->in[I_WOA], A->in[I_WOB], A->in[I_WOUT], A->in[I_WUP], A->in[I_WDN], A->ws, A->in[I_LN1], A->in[I_LN2]); }
            SEAM(1);
        }
        if (IN(2)) for (int rep_ = 0; rep_ < REP(2); ++rep_) {
            { ArgsP A = largs(); const int G = gridDim.x;
              for (int u = lbid(); u < 256; u += G) attn_prompt_unit(lds, u, l, WSP(WS_PROJ, bf16), A->in[I_LNQ], A->in[I_LNK], A->in[I_SINK], WSP(WS_BIAS, float), WSP(WS_OA, bf16), A->out + O_KP, A->out + O_VP); }
            { ArgsP A = largs(); const int G = gridDim.x;
              for (int u = lbid(); u < 256; u += G) { const int c = u & 31, h = (u >> 5) & 3, b = u >> 7;
                gla_a_unit(lds, l, h, (size_t)b * SEQ + c * GC, WSP(WS_PROJ, bf16), WSP(WS_GK, float), A->in[I_WGK2], A->in[I_BGK], WSP(WS_QT, bf16), WSP(WS_KT, bf16),
                           WSP(WS_GU, float) + ((size_t)((b * 4 + h) * NCH + c)) * 32768, WSP(WS_GDL, float) + ((b * 4 + h) * NCH + c) * 128); } }
            SEAM(2);
        }
        if (IN(3)) for (int rep_ = 0; rep_ < REP(3); ++rep_) {
            { ArgsP A = largs(); gla_scan2(l, WSP(WS_GU, float), WSP(WS_GDL, float), WSP(WS_GS, bf16), A->out + O_GP); }
            { ArgsP A = largs(); const int G = gridDim.x, GH = G >> 1;
              for (int u = lbid(); u < 128 && lbid() < GH; u += GH) { const int h = u & 3, b = u >> 2;
                gla_unit<true>(lds, l, h, (size_t)MP + b * 4, 4, WSP(WS_PROJ, bf16), WSP(WS_GK, float), A->in[I_WGK2], A->in[I_BGK], A->in[I_LNO], A->in[I_SG] + ((size_t)((l * 32 + b) * 4 + h)) * 32768,
                               A->out + O_GS + ((size_t)((l * 32 + b) * 4 + h)) * 32768, nullptr, WSP(WS_OB, bf16)); } }
            { ArgsP A = largs(); const int G = gridDim.x, GH = G >> 1;
              for (int u = lbid() - GH; u >= 0 && u < 128; u += G - GH) attn_sample_unit(lds, u, l, WSP(WS_PROJ, bf16), A->in[I_CK], A->in[I_CV], A->in[I_LNQ], A->in[I_LNK], A->in[I_SINK], WSP(WS_BIAS, float), WSP(WS_OA, bf16), A->out + O_KS, A->out + O_VS); }
            SEAM(3);
        }
        if (IN(4)) for (int rep_ = 0; rep_ < REP(4); ++rep_) {
            ArgsP A = largs(); const int G = gridDim.x;
            for (int u = lbid(); u < 256; u += G) { const int c = u & 31, h = (u >> 5) & 3, b = u >> 7;
                gla_c_unit(lds, l, h, (size_t)b * SEQ + c * GC, WSP(WS_PROJ, bf16), WSP(WS_QT, bf16), WSP(WS_KT, bf16), WSP(WS_GS, bf16) + ((size_t)((b * 4 + h) * NCH + c)) * 32768, A->in[I_LNO], WSP(WS_OB, bf16)); }
            SEAM(4);
        }
        if (IN(5)) for (int rep_ = 0; rep_ < REP(5); ++rep_) {
            { ArgsP A = largs(); pg8::StaticOrder S; S.init(MP, D, gridDim.x, lbid());
              pg8::Gemm g{WSP(WS_OA, bf16), WSW(WS_WOA), MP, D, 2048}; pg8::EpiMix E{WSP(WS_GT, pg8::u32x4), WSP(WS_MIX, bf16)}; pg8::gemm_phase<pg8::EpiMix, pg8::StaticOrder, true, true>(lds, g, S, E); }
            { ArgsP A = largs(); const int G = gridDim.x;
              for (int it = lbid(); it < 256; it += G) skinny_mix(lds, it, WSP(WS_OA, bf16), WSW(WS_WOA), WSP(WS_OB, bf16), WSW(WS_WOB), WSP(WS_PROJ, bf16), WSP(WS_MIX, bf16)); }
            SEAM(5);
        }
        if (IN(6)) for (int rep_ = 0; rep_ < REP(6); ++rep_) {
            ArgsP A = largs();
            pg8::Gemm g{WSP(WS_MIX, bf16), WSW(WS_WOUT), MP, D, D}; pg8::StaticOrder S; S.init(MP, D, gridDim.x, lbid());
            pg8::EpiRes E{WSP(WS_H, bf16), nullptr, WSP(WS_SS1, float)};
            pg8::gemm_phase<pg8::EpiRes, pg8::StaticOrder, true, true>(lds, g, S, E);
            { const int G = gridDim.x; for (int it = lbid(); it < 256; it += G) skinny_res(lds, it, WSP(WS_MIX, bf16), WSW(WS_WOUT), D, WSP(WS_H, bf16), nullptr, WSP(WS_SS1, float)); }
            SEAM(6);
        }
        if (IN(8)) for (int rep_ = 0; rep_ < REP(8); ++rep_) {
            ArgsP A = largs();
            pg8::Gemm g{WSP(WS_H, bf16), WSW(WS_WUP), MPAD, NUP, D}; pg8::StaticOrder S; S.init(MPAD, NUP, gridDim.x, lbid());
            pg8::EpiUp E{WSP(WS_ACT, bf16), WSP(WS_U, bf16), WSP(WS_RAWB, float), WSP(WS_SS1, float), A->in[I_WCONV] + (size_t)l * 3 * NUP, A->in[I_BCONV] + (size_t)l * NUP, (PG8_LAS float*)(lds + RING_BYTES)};
            pg8::gemm_phase<pg8::EpiUp, pg8::StaticOrder, true, true>(lds, g, S, E);
            { const int G = gridDim.x, u2 = (MPAD / 256) * (NUP / 256), first = u2 % G, idle2 = first ? G - first : 0; const CvPlan cp = cvt_plan(G);
              if (idle2 && lbid() >= first) cvt_range(lds, min(l * CV_NIT + cp.X + cp.T1, DEPTH * CV_NIT), min(l * CV_NIT + cp.X + cp.T1 + cp.T2, DEPTH * CV_NIT), (lbid() - first) * 8 + (ltid() >> 6), idle2 * 8,
                                                                       A->in[I_WIN], A->in[I_WOA], A->in[I_WOB], A->in[I_WOUT], A->in[I_WUP], A->in[I_WDN], A->ws, A->in[I_LN1], A->in[I_LN2]); }
            SEAM(8);
        }
        if (IN(9)) for (int rep_ = 0; rep_ < REP(9); ++rep_) { ArgsP A = largs(); phase_convfix(l, WSP(WS_RAWB, float), A->in[I_WCONV], A->in[I_BCONV], WSP(WS_ACT, bf16), A->out + O_CP);
            phase_conv(l, WSP(WS_U, bf16), A->in[I_SC], A->in[I_WCONV], A->in[I_BCONV], WSP(WS_ACT, bf16), A->out + O_CP, A->out + O_CS, 256, 32);
            { const int G = gridDim.x; const CvPlan cp = cvt_plan(G);
              cvt_range(lds, min(l * CV_NIT + cp.X + cp.T1 + cp.T2, DEPTH * CV_NIT), min((l + 1) * CV_NIT + cp.X, DEPTH * CV_NIT), lbid() * 8 + (ltid() >> 6), G * 8,
                        A->in[I_WIN], A->in[I_WOA], A->in[I_WOB], A->in[I_WOUT], A->in[I_WUP], A->in[I_WDN], A->ws, A->in[I_LN1], A->in[I_LN2]); }
            SEAM(9); }
        if (IN(10)) for (int rep_ = 0; rep_ < REP(10); ++rep_) {
            ArgsP A = largs();
            pg8::Gemm g{WSP(WS_ACT, bf16), WSW(WS_WDN), MP, D, DFF}; pg8::StaticOrder S; S.init(MP, D, gridDim.x, lbid());
            const bool lastl = (l == DEPTH - 1);
            pg8::EpiRes E{WSP(WS_H, bf16), lastl ? A->out + O_Y : nullptr, WSP(WS_SS2, float)};
            pg8::gemm_phase<pg8::EpiRes, pg8::StaticOrder, true, true>(lds, g, S, E);
            { const int G = gridDim.x; for (int it = lbid(); it < 256; it += G) skinny_res(lds, it, WSP(WS_ACT, bf16), WSW(WS_WDN), DFF, WSP(WS_H, bf16), lastl ? A->out + O_Y : nullptr, WSP(WS_SS2, float)); }
            SEAM(10);
        }
    }
#undef IN
#undef SEAM
#undef WSP
}

#ifndef HYB_FUSED
#define HYB_FUSED 1
#endif
extern "C" void kernel_launch(void* const* d_in, const int* in_sizes, int n_in, void* d_out, int out_size, void* d_ws, size_t ws_size, hipStream_t stream) {
    static int grid = 0;
    if (grid == 0) {
        if (n_in != 23 || (size_t)out_size != O_END || ws_size < WS_END) { fprintf(stderr, "kernel_launch: unexpected shapes: n_in %d out %d ws %zu (need %zu)\n", n_in, out_size, ws_size, (size_t)WS_END); grid = -1; return; }
        int dev = 0, cus = 0, per_cu = 0;
        if (hipGetDevice(&dev) != hipSuccess || hipDeviceGetAttribute(&cus, hipDeviceAttributeMultiprocessorCount, dev) != hipSuccess) { grid = -1; return; }
        if (hipFuncSetAttribute((const void*)hyb_fwd, hipFuncAttributeMaxDynamicSharedMemorySize, LDS_BYTES) != hipSuccess) { fprintf(stderr, "kernel_launch: hipFuncSetAttribute failed\n"); grid = -1; return; }
        if (hipOccupancyMaxActiveBlocksPerMultiprocessor(&per_cu, (const void*)hyb_fwd, 512, LDS_BYTES) != hipSuccess || per_cu < 1) fprintf(stderr, "kernel_launch: occupancy query says %d\n", per_cu);
        (void)hipGetLastError();
        grid = cus;
    }
    if (grid < 0) return;
    (void)hipMemsetAsync((char*)d_ws + WS_CTL, 0, CTL_BYTES, stream);
    Args a{};
    for (int i = 0; i < 23; ++i) a.in[i] = (const float*)d_in[i];
    a.out = (float*)d_out; a.ws = (unsigned char*)d_ws;
#if HYB_FUSED
    a.l_lo = 0; a.l_hi = DEPTH; a.ph_lo = 0; a.ph_hi = NPH;
    hipLaunchKernelGGL(hyb_fwd, dim3(grid), dim3(512), LDS_BYTES, stream, a);
#else
    for (int l = 0; l < DEPTH; ++l)
        for (int p = 0; p < NPH; ++p) { a.l_lo = l; a.l_hi = l + 1; a.ph_lo = p; a.ph_hi = p + 1; hipLaunchKernelGGL(hyb_fwd, dim3(grid), dim3(512), LDS_BYTES, stream, a); }
#endif
}
```

```cpp
#include <hip/hip_runtime.h>
#include <cstdio>
#include <cstdint>
__device__ __forceinline__ int ltid() { int t = threadIdx.x; asm volatile("" : "+v"(t)); return t; }
__device__ __forceinline__ int lbid() { int t = blockIdx.x; asm volatile("" : "+s"(t)); return t; }
template <int CTRL> __device__ __forceinline__ float dppf(float v) { return __builtin_bit_cast(float, __builtin_amdgcn_update_dpp(0, __builtin_bit_cast(int, v), CTRL, 0xf, 0xf, true)); }
__device__ __forceinline__ float red8_sum(float v) { v += dppf<0xB1>(v); v += dppf<0x4E>(v); v += dppf<0x141>(v); return v; }
__device__ __forceinline__ float red16_sum(float v) { v = red8_sum(v); v += dppf<0x140>(v); return v; }
__device__ __forceinline__ float red16_max(float v) { v = fmaxf(v, dppf<0xB1>(v)); v = fmaxf(v, dppf<0x4E>(v)); v = fmaxf(v, dppf<0x141>(v)); v = fmaxf(v, dppf<0x140>(v)); return v; }
__device__ __forceinline__ float xrows_sum(float v) {
    const unsigned a = __builtin_bit_cast(unsigned, v);
    const auto r = __builtin_amdgcn_permlane16_swap(a, a, false, false);
    unsigned r0 = r[0], r1 = r[1]; asm volatile("" : "+v"(r0), "+v"(r1));
    v = __builtin_bit_cast(float, r0) + __builtin_bit_cast(float, r1);
    const unsigned c = __builtin_bit_cast(unsigned, v);
    const auto q = __builtin_amdgcn_permlane32_swap(c, c, false, false);
    unsigned q0 = q[0], q1 = q[1]; asm volatile("" : "+v"(q0), "+v"(q1));
    return __builtin_bit_cast(float, q0) + __builtin_bit_cast(float, q1);
}
__device__ __forceinline__ float xrows_max(float v) {
    const unsigned a = __builtin_bit_cast(unsigned, v);
    const auto r = __builtin_amdgcn_permlane16_swap(a, a, false, false);
    unsigned r0 = r[0], r1 = r[1]; asm volatile("" : "+v"(r0), "+v"(r1));
    v = fmaxf(__builtin_bit_cast(float, r0), __builtin_bit_cast(float, r1));
    const unsigned c = __builtin_bit_cast(unsigned, v);
    const auto q = __builtin_amdgcn_permlane32_swap(c, c, false, false);
    unsigned q0 = q[0], q1 = q[1]; asm volatile("" : "+v"(q0), "+v"(q1));
    return fmaxf(__builtin_bit_cast(float, q0), __builtin_bit_cast(float, q1));
}
namespace pg8 {
#define PG8_LAS __attribute__((address_space(3)))
typedef unsigned short bf16_t;
typedef short bf16x8 __attribute__((ext_vector_type(8)));
typedef float f32x4 __attribute__((ext_vector_type(4)));
typedef unsigned u32x4 __attribute__((ext_vector_type(4)));
constexpr int BM = 256, BK = 64, HALF = 128, HTB = HALF * BK * 2  , STAGE_BYTES = 8 * HTB, NXCD = 8, WGM = 8;

__host__ __device__ __forceinline__ int lds_byte(int r, int c) { const int st = (r >> 4) * 2 + (c >> 5), rr = r & 15, cc = c & 31, ob = rr * 64 + cc * 2; return st * 1024 + (ob ^ (((ob >> 9) & 1) << 5)); }
__host__ __device__ __forceinline__ void stage_rc(int b, int& R, int& C) { const int st = b / 1024, sb = b % 1024, swz = sb ^ (((sb >> 9) & 1) << 5); R = (st >> 1) * 16 + swz / 64; C = (st & 1) * 32 + (swz % 64) / 2; }
__host__ __device__ __forceinline__ int perm32x(int rho) { const int n = rho >> 4, i = rho & 15, fq = i >> 2, e = i & 3; return 16 * (fq & 1) + 8 * n + 4 * (fq >> 1) + e; }
__host__ __device__ __forceinline__ int perm32(int rho) { const int n = rho >> 4, i = rho & 15; return 8 * (i >> 2) + 4 * n + (i & 3); }

struct Unit { int pm, pn; };
struct Gemm { const bf16_t* A; const bf16_t* Bt; int M, N, K; };

struct StaticOrder {
    int nM, nN, nwg, G, c;
    __host__ __device__ void init(int M, int N, int G_, int c_) { nM = M / BM; nN = N / BM; nwg = nM * nN; G = G_; c = c_; }
    __host__ __device__ bool next(int i, Unit& u) const {
        const long L = (long)i * G + c; if (L >= nwg) return false;
        int wgid = (int)L; { const int q = nwg / NXCD, r = nwg % NXCD, xcd = wgid % NXCD, off = wgid / NXCD; wgid = (xcd < r ? xcd * (q + 1) : r * (q + 1) + (xcd - r) * q) + off; }
        const int nig = WGM * nN, gid = wgid / nig, fm = gid * WGM, gsz = (nM - fm) < WGM ? (nM - fm) : WGM;
        u.pm = fm + ((wgid % nig) % gsz); u.pn = (wgid % nig) / gsz; return true;
    }
    __device__ __forceinline__ void a_ready(const Unit&) const {}
    __device__ __forceinline__ void done(const Unit&) const {}
};

__device__ __forceinline__ unsigned cvt_pk_bf16(float lo, float hi) { unsigned r; asm volatile("v_cvt_pk_bf16_f32 %0, %1, %2" : "=v"(r) : "v"(lo), "v"(hi)); return r; }
typedef float f32x2 __attribute__((ext_vector_type(2)));
typedef __bf16 bf16x2v __attribute__((ext_vector_type(2)));
__device__ __forceinline__ unsigned cvt_pk_bf16_b(float lo, float hi) { const f32x2 v = {lo, hi}; return __builtin_bit_cast(unsigned, __builtin_convertvector(v, bf16x2v)); }

typedef unsigned u32x2 __attribute__((ext_vector_type(2)));
__device__ __forceinline__ float bfl(unsigned w) { return __uint_as_float(w << 16); }
__device__ __forceinline__ float bfh(unsigned w) { return __uint_as_float(w & 0xffff0000u); }
__device__ __forceinline__ float sigm(float x) { return __builtin_amdgcn_rcpf(1.0f + __expf(-x)); }

__device__ __forceinline__ void stage_rstd(const float* SS, int pm, int tid_, PG8_LAS float* RSL) {
    const int r = tid_ >> 1, h = tid_ & 1;
    f32x4 t = {0.f, 0.f, 0.f, 0.f};
    if (pm < 32) { const f32x4* sp = (const f32x4*)(SS + (size_t)(pm * 256 + r) * 32 + h * 16); t = (sp[0] + sp[1]) + (sp[2] + sp[3]); }
    else if (r < 128) { const f32x4* sp = (const f32x4*)(SS + (size_t)8192 * 32 + (size_t)r * 128 + h * 64);
#pragma unroll
        for (int i = 0; i < 16; ++i) t += sp[i]; }
    float s_ = (t[0] + t[1]) + (t[2] + t[3]);
    s_ += dppf<0xB1>(s_);
    if (h == 0) RSL[r] = __builtin_amdgcn_rsqf(s_ * (1.0f / 2048.0f) + 1e-6f);
}
struct EpiBf {
    static constexpr bool PERM = true, AFTER_DRAIN = false, HAS_MID = true, PERMA = false, PERMB = false;
    u32x4* GT; int gt0;
    bf16_t* O; int ldc; float* GK; int gkt; const float* SS; PG8_LAS float* RSL;
    __device__ __forceinline__ void mid(f32x4 (&acc)[2][2][4][2], const Unit& u, int wr, int wc, int fr, int fq) const {
        asm volatile("" : "+v"(fr));
        stage_rstd(SS, u.pm, (wr * 4 + wc) * 64 + fq * 16 + fr, RSL);
    }
    __device__ __forceinline__ void operator()(const f32x4 (&acc)[2][2][4][2], const Unit& u, int wr, int wc, int fr, int fq) const {
        const int row0 = u.pm * BM + wr * 64 + fr;
        float rs[2][4];
#pragma unroll
        for (int ai = 0; ai < 2; ++ai)
#pragma unroll
            for (int m = 0; m < 4; ++m) rs[ai][m] = RSL[wr * 64 + fr + ai * HALF + m * 16];
        if (u.pn == gkt) {
            if (wc == 0 && fq < 2) {
#pragma unroll
                for (int ai = 0; ai < 2; ++ai)
#pragma unroll
                    for (int m = 0; m < 4; ++m) { float* gp = GK + (size_t)(row0 + ai * HALF + m * 16) * 16 + 8 * fq;
                        *(f32x4*)(gp) = acc[ai][0][m][0] * rs[ai][m]; *(f32x4*)(gp + 4) = acc[ai][0][m][1] * rs[ai][m]; }
            }
            return;
        }
        if (GT != nullptr && u.pm < 32 && u.pn >= gt0 && u.pn < gt0 + 16) {
            u32x4* gp = GT + ((size_t)(u.pm * 16 + (u.pn - gt0)) * 16) * 512 + (wr * 4 + wc) * 64 + fq * 16 + fr;
#pragma unroll
            for (int ai = 0; ai < 2; ++ai)
#pragma unroll
                for (int m = 0; m < 4; ++m) { const float r = rs[ai][m];
#pragma unroll
                    for (int bj = 0; bj < 2; ++bj) { const f32x4 v0 = acc[ai][bj][m][0] * r, v1 = acc[ai][bj][m][1] * r;
                        u32x4 w; w.x = cvt_pk_bf16(v0[0], v0[1]); w.y = cvt_pk_bf16(v0[2], v0[3]); w.z = cvt_pk_bf16(v1[0], v1[1]); w.w = cvt_pk_bf16(v1[2], v1[3]);
                        gp[((ai * 4 + m) * 2 + bj) * 512] = w; } }
            return;
        }
        const int col0 = u.pn * BM + wc * 32 + 8 * fq;
#pragma unroll
        for (int ai = 0; ai < 2; ++ai)
#pragma unroll
            for (int m = 0; m < 4; ++m) { bf16_t* rowp = O + (size_t)(row0 + ai * HALF + m * 16) * ldc + col0; const float r = rs[ai][m];
#pragma unroll
                for (int bj = 0; bj < 2; ++bj) { const f32x4 v0 = acc[ai][bj][m][0] * r, v1 = acc[ai][bj][m][1] * r;
                    u32x4 w; w.x = cvt_pk_bf16(v0[0], v0[1]); w.y = cvt_pk_bf16(v0[2], v0[3]); w.z = cvt_pk_bf16(v1[0], v1[1]); w.w = cvt_pk_bf16(v1[2], v1[3]);
                    *(u32x4*)(rowp + bj * HALF) = w; } }
    }
};
struct EpiMix {
    static constexpr bool PERM = true, AFTER_DRAIN = false, HAS_MID = true, PERMA = false, PERMB = false;
    const u32x4* GT; bf16_t* O;
    __device__ __forceinline__ float rat(float gb, float ga) const { return (1.0f + __expf(-gb)) * __builtin_amdgcn_rcpf(1.0f + __expf(-ga)); }
    __device__ __forceinline__ void mid(f32x4 (&acc)[2][2][4][2], const Unit& u, int wr, int wc, int fr, int fq) const {
        asm volatile("" : "+v"(fr));
        const u32x4* ga_p = GT + ((size_t)(u.pm * 16 + u.pn) * 16) * 512 + (wr * 4 + wc) * 64 + fq * 16 + fr; const u32x4* gb_p = ga_p + (size_t)8 * 16 * 512;
#pragma unroll
        for (int q4 = 0; q4 < 4; ++q4) {
            u32x4 gav[4], gbv[4];
#pragma unroll
            for (int k = 0; k < 4; ++k) { gav[k] = ga_p[(q4 * 4 + k) * 512]; gbv[k] = gb_p[(q4 * 4 + k) * 512]; }
#pragma unroll
            for (int k = 0; k < 4; ++k) { const int gi = q4 * 4 + k, ai = gi >> 3, m = (gi >> 1) & 3, bj = gi & 1;
                const u32x4 ga = gav[k], gb = gbv[k];
                f32x4 a0 = acc[ai][bj][m][0], a1 = acc[ai][bj][m][1];
                a0[0] *= rat(bfl(gb.x), bfl(ga.x)); a0[1] *= rat(bfh(gb.x), bfh(ga.x)); a0[2] *= rat(bfl(gb.y), bfl(ga.y)); a0[3] *= rat(bfh(gb.y), bfh(ga.y));
                a1[0] *= rat(bfl(gb.z), bfl(ga.z)); a1[1] *= rat(bfh(gb.z), bfh(ga.z)); a1[2] *= rat(bfl(gb.w), bfl(ga.w)); a1[3] *= rat(bfh(gb.w), bfh(ga.w));
                acc[ai][bj][m][0] = a0; acc[ai][bj][m][1] = a1; }
            asm volatile("" ::: "memory"); __builtin_amdgcn_sched_barrier(0);
        }
    }
    __device__ __forceinline__ void operator()(const f32x4 (&acc)[2][2][4][2], const Unit& u, int wr, int wc, int fr, int fq) const {
        const int row0 = u.pm * BM + wr * 64 + fr, col0 = u.pn * BM + wc * 32 + 8 * fq;
        const u32x4* gb_p = GT + ((size_t)(u.pm * 16 + 8 + u.pn) * 16) * 512 + (wr * 4 + wc) * 64 + fq * 16 + fr;
#pragma unroll
        for (int h2 = 0; h2 < 2; ++h2) {
            u32x4 gv[8];
#pragma unroll
            for (int k = 0; k < 8; ++k) gv[k] = gb_p[(h2 * 8 + k) * 512];
#pragma unroll
            for (int k = 0; k < 8; ++k) { const int gi = h2 * 8 + k, ai = gi >> 3, m = (gi >> 1) & 3, bj = gi & 1;
                const size_t row = (size_t)(row0 + ai * HALF + m * 16); const int c = col0 + bj * HALF;
                const u32x4 gw = gv[k];
                const f32x4 a0 = acc[ai][bj][m][0], a1 = acc[ai][bj][m][1];
                u32x4 w; w.x = cvt_pk_bf16(sigm(bfl(gw.x)) * a0[0], sigm(bfh(gw.x)) * a0[1]); w.y = cvt_pk_bf16(sigm(bfl(gw.y)) * a0[2], sigm(bfh(gw.y)) * a0[3]);
                w.z = cvt_pk_bf16(sigm(bfl(gw.z)) * a1[0], sigm(bfh(gw.z)) * a1[1]); w.w = cvt_pk_bf16(sigm(bfl(gw.w)) * a1[2], sigm(bfh(gw.w)) * a1[3]);
                *(u32x4*)(O + row * 2048 + c) = w; }
            asm volatile("" ::: "memory");
        }
    }
};
__device__ __forceinline__ float dpp_shr1(float v) { return __builtin_bit_cast(float, __builtin_amdgcn_update_dpp(0, __builtin_bit_cast(int, v), 0x111, 0xf, 0xf, true)); }
__device__ __forceinline__ float dpp_shr2(float v) { return __builtin_bit_cast(float, __builtin_amdgcn_update_dpp(0, __builtin_bit_cast(int, v), 0x112, 0xf, 0xf, true)); }
__device__ __forceinline__ float dpp_shl15(float v) { return __builtin_bit_cast(float, __builtin_amdgcn_update_dpp(0, __builtin_bit_cast(int, v), 0x10F, 0xf, 0xf, true)); }
__device__ __forceinline__ float dpp_shl14(float v) { return __builtin_bit_cast(float, __builtin_amdgcn_update_dpp(0, __builtin_bit_cast(int, v), 0x10E, 0xf, 0xf, true)); }
__device__ __forceinline__ float gelu_t(float x) { const float z = 1.5957691216057308f * (x + 0.044715f * x * x * x); return x * __builtin_amdgcn_rcpf(1.0f + __expf(-z)); }
struct EpiUp {
    static constexpr bool PERM = true, AFTER_DRAIN = false, HAS_MID = true, PERMA = true, PERMB = true;
    bf16_t* ACT; bf16_t* U; float* RAWB; const float* SS; const float* wconv; const float* bconv; PG8_LAS float* XCH;
    __device__ __forceinline__ void mid(f32x4 (&acc)[2][2][4][2], const Unit& u, int wr, int wc, int fr, int fq) const {
        asm volatile("" : "+v"(fr));
        stage_rstd(SS, u.pm, (wr * 4 + wc) * 64 + fq * 16 + fr, XCH + 3072);
    }
    __device__ __forceinline__ void operator()(const f32x4 (&acc)[2][2][4][2], const Unit& u, int wr, int wc, int fr, int fq) const {
        asm volatile("" : "+v"(fr), "+v"(fq));
        const int row0 = u.pm * BM + wr * 64 + 4 * fr, cl = wc * 32 + 16 * (fq & 1) + 4 * (fq >> 1);
        float rs[2][4];
#pragma unroll
        for (int ai = 0; ai < 2; ++ai) { const f32x4 r4 = *(const PG8_LAS f32x4*)(XCH + 3072 + ai * HALF + wr * 64 + 4 * fr);
#pragma unroll
            for (int m = 0; m < 4; ++m) rs[ai][m] = r4[m]; }
        if (u.pm == 32) {
#pragma unroll
            for (int ai = 0; ai < 2; ++ai)
#pragma unroll
                for (int m = 0; m < 4; ++m) { const int row = row0 + ai * HALF + m;
                    if (row < 8320) {
#pragma unroll
                        for (int bj = 0; bj < 2; ++bj)
#pragma unroll
                            for (int n = 0; n < 2; ++n) { const f32x4 v0 = acc[ai][bj][m][n] * rs[ai][m];
                                u32x2 w; w.x = cvt_pk_bf16(v0[0], v0[1]); w.y = cvt_pk_bf16(v0[2], v0[3]);
                                *(u32x2*)(U + (size_t)row * 11264 + bj * 5632 + 128 * u.pn + cl + 8 * n) = w; } } }
            return;
        }
        if (fr == 15) {
#pragma unroll
            for (int ai = 0; ai < 2; ++ai)
#pragma unroll
                for (int bj = 0; bj < 2; ++bj)
#pragma unroll
                    for (int n = 0; n < 2; ++n) { PG8_LAS float* xp = XCH + ((ai * 2 + wr) * 2) * 256 + bj * 128 + cl + 8 * n;
                        *(PG8_LAS f32x4*)xp = acc[ai][bj][2][n] * rs[ai][2]; *(PG8_LAS f32x4*)(xp + 256) = acc[ai][bj][3][n] * rs[ai][3]; }
            if (wr == 1) {
#pragma unroll
                for (int bj = 0; bj < 2; ++bj)
#pragma unroll
                    for (int n = 0; n < 2; ++n) { float* rp = RAWB + ((size_t)(u.pm * 44 + u.pn) * 4 + 2) * 256 + bj * 128 + cl + 8 * n;
                        *(f32x4*)rp = acc[1][bj][2][n] * rs[1][2]; *(f32x4*)(rp + 256) = acc[1][bj][3][n] * rs[1][3]; }
            }
        }
        if (wr == 0 && fr == 0) {
#pragma unroll
            for (int bj = 0; bj < 2; ++bj)
#pragma unroll
                for (int n = 0; n < 2; ++n) { float* rp = RAWB + ((size_t)(u.pm * 44 + u.pn) * 4) * 256 + bj * 128 + cl + 8 * n;
                    *(f32x4*)rp = acc[0][bj][0][n] * rs[0][0]; *(f32x4*)(rp + 256) = acc[0][bj][1][n] * rs[0][1]; }
        }
        {
            PG8_LAS float* WL = XCH + 2048;
            const int tid_ = (wr * 4 + wc) * 64 + fq * 16 + fr, v = tid_ >> 6, c2 = (tid_ & 63) * 2;
            const float* src = (v & 3) == 3 ? bconv + (v >> 2) * 5632 : wconv + (v & 3) * 11264 + (v >> 2) * 5632;
            *(PG8_LAS f32x2*)(WL + v * 128 + c2) = *(const f32x2*)(src + 128 * u.pn + c2);
        }
        asm volatile("s_waitcnt lgkmcnt(0)" ::: "memory"); __builtin_amdgcn_s_barrier(); asm volatile("" ::: "memory");
        unsigned hold[2][4];
        const bool upper = fq >= 2;
        const int cstore = wc * 32 + 16 * (fq & 1);
#pragma unroll
        for (int nn = 0; nn < 4; ++nn) {
            const int n = nn >> 1, eh = nn & 1, j0 = 128 * u.pn + cl + 8 * n + 2 * eh;
            const PG8_LAS float* wl = XCH + 2048 + cl + 8 * n + 2 * eh;
            const f32x2 w0v = *(const PG8_LAS f32x2*)(wl), w1v = *(const PG8_LAS f32x2*)(wl + 128), w2v = *(const PG8_LAS f32x2*)(wl + 256), bv = *(const PG8_LAS f32x2*)(wl + 384);
            const f32x2 w0g = *(const PG8_LAS f32x2*)(wl + 512), w1g = *(const PG8_LAS f32x2*)(wl + 640), w2g = *(const PG8_LAS f32x2*)(wl + 768), bg = *(const PG8_LAS f32x2*)(wl + 896);
#pragma unroll
            for (int ai = 0; ai < 2; ++ai) {
                const int q = ai * 2 + wr;
                f32x2 xv[4], xg[4];
                const f32x4 r4 = *(const PG8_LAS f32x4*)(XCH + 3072 + ai * HALF + wr * 64 + 4 * fr);
#pragma unroll
                for (int m = 0; m < 4; ++m) { const float r = r4[m];
                    xv[m] = (f32x2){acc[ai][0][m][n][2 * eh] * r, acc[ai][0][m][n][2 * eh + 1] * r}; xg[m] = (f32x2){acc[ai][1][m][n][2 * eh] * r, acc[ai][1][m][n][2 * eh + 1] * r}; }
                f32x2 l2v = {0.f, 0.f}, l3v = l2v, l2g = l2v, l3g = l2v;
                if (q > 0) { const PG8_LAS float* xp = XCH + ((q - 1) * 2) * 256 + cl + 8 * n + 2 * eh;
                    l2v = *(const PG8_LAS f32x2*)xp; l3v = *(const PG8_LAS f32x2*)(xp + 256); l2g = *(const PG8_LAS f32x2*)(xp + 128); l3g = *(const PG8_LAS f32x2*)(xp + 256 + 128); }
                const bool f0 = fr == 0;
                const f32x2 s3v = {dpp_shr1(xv[3][0]) + (f0 ? l3v[0] : 0.f), dpp_shr1(xv[3][1]) + (f0 ? l3v[1] : 0.f)}, s2v = {dpp_shr1(xv[2][0]) + (f0 ? l2v[0] : 0.f), dpp_shr1(xv[2][1]) + (f0 ? l2v[1] : 0.f)};
                const f32x2 s3g = {dpp_shr1(xg[3][0]) + (f0 ? l3g[0] : 0.f), dpp_shr1(xg[3][1]) + (f0 ? l3g[1] : 0.f)}, s2g = {dpp_shr1(xg[2][0]) + (f0 ? l2g[0] : 0.f), dpp_shr1(xg[2][1]) + (f0 ? l2g[1] : 0.f)};
                unsigned pwv[4];
#pragma unroll
                for (int m = 0; m < 4; ++m) {
                    const f32x2 p1v = m == 0 ? s3v : xv[m - 1 < 0 ? 0 : m - 1], p2v = m == 0 ? s2v : (m == 1 ? s3v : xv[m - 2 < 0 ? 0 : m - 2]);
                    const f32x2 p1g = m == 0 ? s3g : xg[m - 1 < 0 ? 0 : m - 1], p2g = m == 0 ? s2g : (m == 1 ? s3g : xg[m - 2 < 0 ? 0 : m - 2]);
                    const f32x2 vc = w0v * p2v + w1v * p1v + w2v * xv[m] + bv, gc = w0g * p2g + w1g * p1g + w2g * xg[m] + bg;
                    const f32x2 gw = (gc * gc) * (-0.10294324f) + (-2.3022082f), gz = gc * gw;
                    f32x2 gd; gd[0] = __builtin_amdgcn_rcpf(1.0f + __builtin_amdgcn_exp2f(gz[0])); gd[1] = __builtin_amdgcn_rcpf(1.0f + __builtin_amdgcn_exp2f(gz[1]));
                    const f32x2 av = (gc * gd) * vc;
                    pwv[m] = cvt_pk_bf16(av[0], av[1]);
                    if (eh == 0) hold[ai][m] = pwv[m];
                }
                if (eh == 1) {
#pragma unroll
                    for (int pr = 0; pr < 2; ++pr) {
                        unsigned a0 = hold[ai][2 * pr], a1 = pwv[2 * pr], b0 = hold[ai][2 * pr + 1], b1 = pwv[2 * pr + 1];
                        asm volatile("s_nop 1" : "+v"(a0), "+v"(a1), "+v"(b0), "+v"(b1));
                        { auto r = __builtin_amdgcn_permlane32_swap(a0, b0, false, false); a0 = r[0]; b0 = r[1]; }
                        { auto r = __builtin_amdgcn_permlane32_swap(a1, b1, false, false); a1 = r[0]; b1 = r[1]; }
                        if (!(q == 0 && pr == 0 && f0)) { u32x4 w; w.x = a0; w.y = a1; w.z = b0; w.w = b1;
                            *(u32x4*)(ACT + (size_t)(row0 + ai * HALF + 2 * pr + (upper ? 1 : 0)) * 5632 + 128 * u.pn + cstore + 8 * n) = w; }
                    }
                }
            }
            __builtin_amdgcn_sched_barrier(0);
        }
    }
};
struct EpiRes {
    static constexpr bool PERM = true, AFTER_DRAIN = false, HAS_MID = false, PERMA = false, PERMB = false;
    bf16_t* XB; float* Yf; float* SS;
    __device__ __forceinline__ void operator()(const f32x4 (&acc)[2][2][4][2], const Unit& u, int wr, int wc, int fr, int fq) const {
        const int row0 = u.pm * BM + wr * 64 + fr, col0 = u.pn * BM + wc * 32 + 8 * fq;
#pragma unroll
        for (int ai = 0; ai < 2; ++ai)
#pragma unroll
            for (int m = 0; m < 4; ++m) { const int row = row0 + ai * HALF + m * 16; const size_t off = (size_t)row * 2048 + col0; float ss = 0.f;
#pragma unroll
                for (int bj = 0; bj < 2; ++bj) { const u32x4 xw = *(const u32x4*)(XB + off + bj * HALF);
                    f32x4 y0 = acc[ai][bj][m][0], y1 = acc[ai][bj][m][1];
                    y0[0] += bfl(xw.x); y0[1] += bfh(xw.x); y0[2] += bfl(xw.y); y0[3] += bfh(xw.y); y1[0] += bfl(xw.z); y1[1] += bfh(xw.z); y1[2] += bfl(xw.w); y1[3] += bfh(xw.w);
                    if (Yf) { *(f32x4*)(Yf + off + bj * HALF) = y0; *(f32x4*)(Yf + off + bj * HALF + 4) = y1; }
                    else { u32x4 w; w.x = cvt_pk_bf16(y0[0], y0[1]); w.y = cvt_pk_bf16(y0[2], y0[3]); w.z = cvt_pk_bf16(y1[0], y1[1]); w.w = cvt_pk_bf16(y1[2], y1[3]);
                        *(u32x4*)(XB + off + bj * HALF) = w;
                        const float r0 = bfl(w.x), r1 = bfh(w.x), r2 = bfl(w.y), r3 = bfh(w.y), r4 = bfl(w.z), r5 = bfh(w.z), r6 = bfl(w.w), r7 = bfh(w.w);
                        ss += ((r0 * r0 + r1 * r1) + (r2 * r2 + r3 * r3)) + ((r4 * r4 + r5 * r5) + (r6 * r6 + r7 * r7)); } }
                if (!Yf) { ss = xrows_sum(ss); if (fq == 0) SS[(size_t)row * 32 + u.pn * 4 + wc] = ss; } }
    }
};
template <class Epi, class Sched, bool ALIGN_EPI = false, bool SP2 = false>
__device__ __forceinline__ void gemm_phase(PG8_LAS unsigned char* lds, const Gemm g, const Sched& S, const Epi& E) {
    const int tid = ltid(), wid = __builtin_amdgcn_readfirstlane(tid >> 6), lane = tid & 63, wr = wid >> 2, wc = wid & 3, fr = lane & 15, fq = lane >> 4;
    const int K = g.K, nt = K / BK;
    unsigned voffA[2], voffB[2];
#pragma unroll
    for (int i = 0; i < 2; ++i) { int R, C; stage_rc(tid * 16 + i * 8192, R, C); const int Rb = Epi::PERM ? ((R & ~31) + (Epi::PERMB ? perm32x(R & 31) : perm32(R & 31))) : R;
        const int Ra = Epi::PERMA ? ((R & ~63) + 4 * (R & 15) + ((R >> 4) & 3)) : R;
        voffA[i] = (unsigned)(Ra * K + C) * 2u; voffB[i] = (unsigned)(Rb * K + C) * 2u; }
    const size_t kstep = (size_t)(BK * 2);
    const size_t hstep = (size_t)HALF * K * 2;
    const size_t tstep = 2 * hstep;
    const unsigned ldsw = (unsigned)wid * 1024u;
    const int aoff = lds_byte(wr * 64 + fr, fq * 8), boff = lds_byte(wc * 32 + fr, fq * 8);
#define PG8_SA(b, h) (((b) * 2 + (h)) * HTB)
#define PG8_SB(b, h) ((4 + (b) * 2 + (h)) * HTB)
#define PG8_STAGE(bufoff, gbase, voff) do { _Pragma("unroll") for (int _i = 0; _i < 2; ++_i) \
        __builtin_amdgcn_global_load_lds((const unsigned*)((const char*)(gbase) + (voff)[_i]), (PG8_LAS unsigned*)(lds + (bufoff) + ldsw + _i * 8192), 16, 0, 0); } while (0)
#define PG8_LDA(dst, b, h) do { _Pragma("unroll") for (int m = 0; m < 4; ++m) _Pragma("unroll") for (int k = 0; k < 2; ++k) dst[m][k] = *(const PG8_LAS bf16x8*)(lds + PG8_SA(b, h) + aoff + m * 2048 + k * 1024); } while (0)
#define PG8_LDB(dst, b, h) do { _Pragma("unroll") for (int n = 0; n < 2; ++n) _Pragma("unroll") for (int k = 0; k < 2; ++k) dst[n][k] = *(const PG8_LAS bf16x8*)(lds + PG8_SB(b, h) + boff + n * 2048 + k * 1024); } while (0)
#define PG8_MMA(ai, bj, At, Bt) do { __builtin_amdgcn_s_setprio(1); _Pragma("unroll") for (int k = 0; k < 2; ++k) _Pragma("unroll") for (int m = 0; m < 4; ++m) _Pragma("unroll") for (int n = 0; n < 2; ++n) \
        acc[ai][bj][m][n] = __builtin_amdgcn_mfma_f32_16x16x32_bf16(Bt[n][k], At[m][k], acc[ai][bj][m][n], 0, 0, 0); __builtin_amdgcn_s_setprio(0); } while (0)
#define PG8_WAIT_V(n) asm volatile("s_waitcnt vmcnt(" #n ")" ::: "memory")
#define PG8_WAIT_L(n) asm volatile("s_waitcnt lgkmcnt(" #n ")" ::: "memory")
#define PG8_BAR __builtin_amdgcn_s_barrier()
#define PG8_SCHED __builtin_amdgcn_sched_barrier(0)
    Unit cur, nxt; int ui = 0;
    if (!S.next(0, cur)) return;
    f32x4 acc[2][2][4][2];
#pragma unroll
    for (int a = 0; a < 2; ++a)
#pragma unroll
        for (int b = 0; b < 2; ++b)
#pragma unroll
            for (int m = 0; m < 4; ++m)
#pragma unroll
                for (int n = 0; n < 2; ++n) acc[a][b][m][n] = (f32x4){0.f, 0.f, 0.f, 0.f};
    bf16x8 At[4][2], B0[2][2], B1[2][2];
    const char* cA = (const char*)g.A + (size_t)cur.pm * tstep; const char* cB = (const char*)g.Bt + (size_t)cur.pn * tstep;
    S.a_ready(cur);
    if constexpr (SP2) {
        PG8_STAGE(PG8_SB(0, 0), cB, voffB); PG8_STAGE(PG8_SB(0, 1), cB + hstep, voffB); PG8_STAGE(PG8_SA(0, 0), cA, voffA); PG8_STAGE(PG8_SA(0, 1), cA + hstep, voffA);
        if (wr == 1) PG8_BAR;
        PG8_WAIT_V(2); PG8_BAR;
        PG8_STAGE(PG8_SB(1, 0), cB + kstep, voffB); PG8_STAGE(PG8_SA(1, 0), cA + kstep, voffA); PG8_STAGE(PG8_SB(1, 1), cB + hstep + kstep, voffB);
        PG8_WAIT_V(6); PG8_BAR;
    } else {
        PG8_STAGE(PG8_SB(0, 0), cB, voffB); PG8_STAGE(PG8_SA(0, 0), cA, voffA); PG8_STAGE(PG8_SB(0, 1), cB + hstep, voffB); PG8_STAGE(PG8_SA(0, 1), cA + hstep, voffA);
        if (wr == 1) PG8_BAR;
        PG8_WAIT_V(4); PG8_BAR;
        PG8_STAGE(PG8_SB(1, 0), cB + kstep, voffB); PG8_STAGE(PG8_SA(1, 0), cA + kstep, voffA); PG8_STAGE(PG8_SB(1, 1), cB + hstep + kstep, voffB);
        PG8_WAIT_V(6); PG8_BAR;
    }
    for (;;) {
        const bool has_next = S.next(ui + 1, nxt);
        const char* nA = has_next ? (const char*)g.A + (size_t)nxt.pm * tstep : cA; const char* nB = has_next ? (const char*)g.Bt + (size_t)nxt.pn * tstep : cB;
        for (int t = 0; t < nt; t += 2) {
            const bool last = (t == nt - 2);
            const char* a1 = cA + (size_t)(t + 1) * kstep;
            const char* a2 = last ? nA : cA + (size_t)(t + 2) * kstep; const char* b2 = last ? nB : cB + (size_t)(t + 2) * kstep;
            const char* a3 = a2 + kstep; const char* b3 = b2 + kstep;
            if (last && has_next) S.a_ready(nxt);
            if constexpr (Epi::HAS_MID) { if (t == (nt >> 1)) { PG8_SCHED; E.mid(acc, cur, wr, wc, fr, fq); PG8_SCHED; } }
            if constexpr (SP2) {
            PG8_LDB(B0, 0, 0); PG8_LDB(B1, 0, 1); PG8_SCHED; PG8_LDA(At, 0, 0); PG8_STAGE(PG8_SA(1, 1), a1 + hstep, voffA);
            PG8_WAIT_V(8); PG8_WAIT_L(0); PG8_BAR; PG8_MMA(0, 0, At, B0); PG8_MMA(0, 1, At, B1); PG8_BAR; PG8_SCHED;
            PG8_LDA(At, 0, 1); PG8_STAGE(PG8_SB(0, 0), b2, voffB); PG8_STAGE(PG8_SB(0, 1), b2 + hstep, voffB); PG8_STAGE(PG8_SA(0, 0), a2, voffA);
            PG8_WAIT_V(8); PG8_WAIT_L(0); PG8_BAR; PG8_MMA(1, 0, At, B0); PG8_MMA(1, 1, At, B1); PG8_BAR; PG8_SCHED;
            PG8_LDB(B0, 1, 0); PG8_LDB(B1, 1, 1); PG8_SCHED; PG8_LDA(At, 1, 0); PG8_STAGE(PG8_SA(0, 1), a2 + hstep, voffA);
            PG8_WAIT_V(8); PG8_WAIT_L(0); PG8_BAR; PG8_MMA(0, 0, At, B0); PG8_MMA(0, 1, At, B1); PG8_BAR; PG8_SCHED;
            PG8_LDA(At, 1, 1); PG8_STAGE(PG8_SB(1, 0), b3, voffB); PG8_STAGE(PG8_SB(1, 1), b3 + hstep, voffB); PG8_STAGE(PG8_SA(1, 0), a3, voffA);
            PG8_WAIT_V(8); PG8_WAIT_L(0); PG8_BAR; PG8_MMA(1, 0, At, B0); PG8_MMA(1, 1, At, B1); PG8_BAR; PG8_SCHED;
            } else {
            PG8_LDB(B0, 0, 0); PG8_SCHED; PG8_LDA(At, 0, 0); PG8_STAGE(PG8_SA(1, 1), a1 + hstep, voffA);
            PG8_WAIT_L(8); PG8_BAR; PG8_WAIT_L(0); PG8_MMA(0, 0, At, B0); PG8_BAR; PG8_SCHED;
            PG8_LDB(B1, 0, 1); PG8_STAGE(PG8_SB(0, 0), b2, voffB);
            PG8_BAR; PG8_WAIT_L(0); PG8_MMA(0, 1, At, B1); PG8_BAR;
            PG8_LDA(At, 0, 1); PG8_STAGE(PG8_SA(0, 0), a2, voffA);
            PG8_BAR; PG8_WAIT_L(0); PG8_MMA(1, 0, At, B0); PG8_BAR; PG8_SCHED;
            PG8_STAGE(PG8_SB(0, 1), b2 + hstep, voffB);
            PG8_WAIT_V(6); PG8_BAR; PG8_MMA(1, 1, At, B1); PG8_BAR;
            PG8_LDB(B0, 1, 0); PG8_SCHED; PG8_LDA(At, 1, 0); PG8_STAGE(PG8_SA(0, 1), a2 + hstep, voffA);
            PG8_WAIT_L(8); PG8_BAR; PG8_WAIT_L(0); PG8_MMA(0, 0, At, B0); PG8_BAR; PG8_SCHED;
            PG8_LDB(B1, 1, 1); PG8_STAGE(PG8_SB(1, 0), b3, voffB);
            PG8_BAR; PG8_WAIT_L(0); PG8_MMA(0, 1, At, B1); PG8_BAR;
            PG8_LDA(At, 1, 1); PG8_STAGE(PG8_SA(1, 0), a3, voffA);
            PG8_BAR; PG8_WAIT_L(0); PG8_MMA(1, 0, At, B0); PG8_BAR; PG8_SCHED;
            PG8_STAGE(PG8_SB(1, 1), b3 + hstep, voffB);
            PG8_WAIT_V(6); PG8_BAR; PG8_MMA(1, 1, At, B1); PG8_BAR;
            }
        }
        if constexpr (ALIGN_EPI) { if (wr == 0) PG8_BAR; }
        if constexpr (!Epi::AFTER_DRAIN) { E(acc, cur, wr, wc, fr, fq); S.done(cur); }
        if (!has_next) break;
#pragma unroll
        for (int a = 0; a < 2; ++a)
#pragma unroll
            for (int b = 0; b < 2; ++b)
#pragma unroll
                for (int m = 0; m < 4; ++m)
#pragma unroll
                    for (int n = 0; n < 2; ++n) acc[a][b][m][n] = (f32x4){0.f, 0.f, 0.f, 0.f};
        cur = nxt; cA = nA; cB = nB; ++ui;
        if constexpr (ALIGN_EPI) { if (wr == 1) PG8_BAR; }
    }
    PG8_WAIT_V(0);
    if constexpr (!ALIGN_EPI) { if (wr == 0) PG8_BAR; }
    PG8_BAR;
    if constexpr (Epi::AFTER_DRAIN) { E.fused(acc, cur, wr, wc, fr, fq, lds, wid, lane); S.done(cur); }
#undef PG8_SA
#undef PG8_SB
#undef PG8_STAGE
#undef PG8_LDA
#undef PG8_LDB
#undef PG8_MMA
#undef PG8_WAIT_V
#undef PG8_WAIT_L
#undef PG8_BAR
#undef PG8_SCHED
}
}

constexpr int D = 2048, MP = 8192, MS = 128, MREAL = 8320, MPAD = 8448, SEQ = 4096, DEPTH = 4;
constexpr int NIN_SRC = 8720, NIN = 8960;
constexpr int C_QA = 0, C_KA = 1024, C_VA = 1280, C_QB = 1536, C_KB = 2048, C_VB = 2560, C_RB = 3584, C_GA = 4608, C_GB = 6656, C_GK = 8704;
constexpr int DFF = 5632, NUP = 11264;
constexpr int GC = 128, NCH = SEQ / GC;
constexpr float EPS = 1e-6f;
constexpr size_t O_Y = 0, O_KP = 17039360, O_VP = 17301504, O_GP = 17563648, O_CP = 18612224, O_KS = 18792448, O_VS = 22986752, O_GS = 27181056, O_CS = 43958272, O_END = 46841856;
constexpr size_t al256(size_t x) { return (x + 255) & ~(size_t)255; }
constexpr size_t WS_CTL = 0, CTL_BYTES = 1u << 20;
constexpr size_t WS_BIAS = WS_CTL + CTL_BYTES;
constexpr size_t WS_WIN = WS_BIAS + 8192;
constexpr size_t WS_WOA = WS_WIN + (size_t)NIN * D * 2;
constexpr size_t WS_WOB = WS_WOA + (size_t)1024 * 2;
constexpr size_t WS_WOUT = WS_WOA + (size_t)2048 * 2048 * 2;
constexpr size_t WS_WUP = WS_WOUT + (size_t)2048 * 2048 * 2;
constexpr size_t WS_WDN = WS_WUP + (size_t)NUP * D * 2;
constexpr size_t WS_X = WS_WDN + (size_t)2048 * DFF * 2;
constexpr size_t WS_H = WS_X + (size_t)MPAD * D * 4;
constexpr size_t WS_PROJ = WS_H + (size_t)MPAD * D * 2;
constexpr size_t WS_GK = WS_PROJ + (size_t)MPAD * NIN * 2;
constexpr size_t WS_OA = WS_GK + (size_t)MPAD * 16 * 4;
constexpr size_t WS_OB = WS_OA + (size_t)1024 * 2;
constexpr size_t WS_T = WS_OA + (size_t)MPAD * 2048 * 2;
constexpr size_t WS_MIX = WS_T + (size_t)MPAD * D * 4;
constexpr size_t WS_U = WS_MIX + (size_t)MPAD * D * 2;
constexpr size_t WS_ACT = WS_U + (size_t)MPAD * NUP * 2;
constexpr size_t WS_GU = WS_ACT + (size_t)MPAD * DFF * 2;
constexpr size_t WS_GDL = WS_GU + (size_t)8 * NCH * 32768 * 4;
constexpr size_t WS_GS = WS_GDL + (size_t)8 * NCH * 128 * 4;
constexpr size_t WS_QT = WS_GS + (size_t)8 * NCH * 32768 * 2;
constexpr size_t WS_KT = WS_QT + (size_t)MP * 512 * 2;
constexpr size_t WS_SS1 = WS_KT + (size_t)MP * 512 * 2;
constexpr size_t WS_SS2 = WS_SS1 + (size_t)(MP * 32 + 128 * 128) * 4;
constexpr size_t WS_RS1 = WS_SS2 + (size_t)(MP * 32 + 128 * 128) * 4;
constexpr size_t WS_RS2 = WS_RS1 + (size_t)MPAD * 4;
constexpr size_t WS_W2 = al256(WS_RS2 + (size_t)MPAD * 4);
constexpr size_t WSET_BYTES = WS_X - WS_WIN;
constexpr size_t WS_RAWB = al256(WS_W2 + WSET_BYTES);
constexpr size_t WS_GT = al256(WS_RAWB + (size_t)32 * 44 * 4 * 256 * 4);
constexpr size_t WS_END = WS_GT + (size_t)32 * 16 * 131072;
static_assert(WS_WIN % 256 == 0 && WS_X % 256 == 0 && WS_PROJ % 256 == 0 && WS_GU % 256 == 0, "ws alignment");
constexpr int CW_BAR = 4096;
constexpr int RING_BYTES = 131072, LDS_BYTES = 147456, MISC_OFF = LDS_BYTES - 128;
constexpr int NPH = 11;

#define LAS __attribute__((address_space(3)))
typedef unsigned short bf16;
typedef unsigned v4u __attribute__((ext_vector_type(4)));
typedef unsigned v2u __attribute__((ext_vector_type(2)));
typedef float f32x4 __attribute__((ext_vector_type(4)));
typedef short bf16x8 __attribute__((ext_vector_type(8)));
__device__ __forceinline__ float bfl(unsigned w) { return __uint_as_float(w << 16); }
__device__ __forceinline__ float bfh(unsigned w) { return __uint_as_float(w & 0xffff0000u); }
__device__ __forceinline__ float bf1(bf16 b) { return __uint_as_float((unsigned)b << 16); }
typedef float f32x2_t __attribute__((ext_vector_type(2)));
typedef __bf16 bf16x2_t __attribute__((ext_vector_type(2)));
__device__ __forceinline__ unsigned pk2(float lo, float hi) { const f32x2_t v = {lo, hi}; return __builtin_bit_cast(unsigned, __builtin_convertvector(v, bf16x2_t)); }
__device__ __forceinline__ bf16 f2bf(float f) { return (bf16)(pk2(f, 0.f) & 0xffffu); }
__device__ __forceinline__ float wave_sum(float v) {
    return xrows_sum(red16_sum(v));
}
__device__ __forceinline__ float wave_max(float v) {
    return xrows_max(red16_max(v));
}
#define LDS_WAIT() asm volatile("s_waitcnt lgkmcnt(0)" ::: "memory")
#define XB_TMO      128
#define XB_XCNT(j)  (256  + 64 * (j))
#define XB_XSUB(j)  (1280 + 64 * (j))
#define XB_XGEN(j)  (2304 + 64 * (j))
#define XB_TOP      3328
#define XB_TOPGEN   3392
#define XCD_BAR_WORDS 3456
#define XB_SPIN_CAP (1u << 18)

__device__ __forceinline__ unsigned xb_ld(unsigned* p)              { return __hip_atomic_load(p, __ATOMIC_RELAXED, __HIP_MEMORY_SCOPE_AGENT); }
__device__ __forceinline__ unsigned xb_add(unsigned* p, unsigned v) { return __hip_atomic_fetch_add(p, v, __ATOMIC_RELAXED, __HIP_MEMORY_SCOPE_AGENT); }
__device__ __forceinline__ unsigned xb_xcc_id() { return (unsigned)__builtin_amdgcn_s_getreg((3 << 11) | 20) & 0xFu; }
#define XB_SPIN(cond, bar) do { unsigned _sp = 0; while (cond) { __builtin_amdgcn_s_sleep(1); \
    if ((++_sp & 255u) == 0u) { if (xb_ld(&(bar)[XB_TMO])) break; if (_sp > XB_SPIN_CAP) { atomicAdd(&(bar)[XB_TMO], 1u); break; } } } } while (0)

struct XcdBarrier {
    unsigned* bar; unsigned x;
    volatile LAS unsigned* st;
};

__device__ __forceinline__ XcdBarrier xcd_barrier_post(unsigned* bar, volatile LAS unsigned* st) {
    XcdBarrier b; b.bar = bar; b.x = xb_xcc_id(); b.st = st;
    if (threadIdx.x == 0) (void)xb_add(&bar[XB_XCNT(b.x)], 1u);
    return b;
}
__device__ __forceinline__ void xcd_barrier_complete(unsigned* bar, unsigned x, unsigned& nloc, unsigned& nx) {
    const unsigned G = gridDim.x * gridDim.y * gridDim.z;
    unsigned sum, cnt, mine, sp = 0u;
    for (;;) {
        sum = 0u; cnt = 0u; mine = 0u;
#pragma unroll
        for (unsigned j = 0; j < 16; ++j) { const unsigned c = xb_ld(&bar[XB_XCNT(j)]); sum += c; cnt += (c > 0u) ? 1u : 0u; mine = (j == x) ? c : mine; }
        if (sum == G) break;
        __builtin_amdgcn_s_sleep(1);
        if ((++sp & 255u) == 0u) { if (xb_ld(&bar[XB_TMO])) break; if (sp > XB_SPIN_CAP) { atomicAdd(&bar[XB_TMO], 1u); break; } }
    }
    nloc = mine > 0u ? mine : 1u; nx = cnt > 0u ? cnt : 1u;
}

__device__ __forceinline__ void xcd_barrier(const XcdBarrier& b) {
    asm volatile("s_waitcnt vmcnt(0)" ::: "memory");
    __syncthreads();
    if (threadIdx.x == 0) {
        unsigned* bar = b.bar;
        __builtin_amdgcn_s_waitcnt(0);
        unsigned nloc = b.st[0], nx = b.st[1];
        if (nloc == 0u) { xcd_barrier_complete(bar, b.x, nloc, nx); b.st[0] = nloc; b.st[1] = nx; }
        const unsigned old = xb_add(&bar[XB_XSUB(b.x)], 1u);
        const unsigned gen = old / nloc;
        if (old + 1u == (gen + 1u) * nloc) {
            __builtin_amdgcn_fence(__ATOMIC_RELEASE, "agent");
            asm volatile("s_waitcnt vmcnt(0)" ::: "memory");
            const unsigned og = xb_add(&bar[XB_TOP], 1u);
            const unsigned tg = og / nx;
            if (og + 1u == (tg + 1u) * nx) xb_add(&bar[XB_TOPGEN], 1u);
            else XB_SPIN(xb_ld(&bar[XB_TOPGEN]) == tg, bar);
            __builtin_amdgcn_fence(__ATOMIC_ACQUIRE, "agent");
            xb_add(&bar[XB_XGEN(b.x)], 1u);
            asm volatile("s_waitcnt vmcnt(0)" ::: "memory");
        } else {
            XB_SPIN(xb_ld(&bar[XB_XGEN(b.x)]) == gen, bar);
            __builtin_amdgcn_fence(__ATOMIC_ACQUIRE, "agent");
            asm volatile("s_waitcnt vmcnt(0)" ::: "memory");
        }
    }
    __syncthreads();
}

__device__ __forceinline__ bf16x8 as_frag(v4u w) { return __builtin_bit_cast(bf16x8, w); }
__device__ __forceinline__ float logsig(float x) { return fminf(x, 0.f) - __logf(1.0f + __expf(-fabsf(x))); }
__device__ __forceinline__ float sigm(float x) { return __builtin_amdgcn_rcpf(1.0f + __expf(-x)); }

__device__ __forceinline__ int win_src_col(int nd) { return nd < 4608 ? nd : (nd < 8704 ? nd + 16 : (nd < 8720 ? nd - 8704 + 4608 : -1)); }
constexpr int CV_IN = 32 * (NIN / 64), CV_OA = 16 * 32, CV_OUT = 32 * 32, CV_UP = 32 * (NUP / 64), CV_DN = (DFF / 64) * 32, CV_NIT = CV_IN + 2 * CV_OA + CV_OUT + CV_UP + CV_DN;
struct CvItem { const float* wp; const float* gp; bf16* op; int Nsrc, ldk; bool valid; };
__device__ __forceinline__ CvItem cvt_decode(int it, int lane, const float* w_in, const float* w_oa, const float* w_ob, const float* w_out, const float* w_up, const float* w_dn, unsigned char* wsb, const float* ln1, const float* ln2) {
    const int l = it / CV_NIT;
    unsigned char* wsw = wsb + ((l & 1) ? (WS_W2 - WS_WIN) : (size_t)0);
    const float* W; int ldk, Nsrc, kb, nb, map = 0; bf16* WT; const float* gain = nullptr; int r = it - l * CV_NIT;
    if (r < CV_IN) { W = w_in + (size_t)l * D * NIN_SRC; ldk = D; Nsrc = NIN_SRC; WT = (bf16*)(wsw + WS_WIN); kb = r / (NIN / 64); nb = r % (NIN / 64); map = 1; gain = ln1 + (size_t)l * D; }
    else if ((r -= CV_IN) < CV_OA) { W = w_oa + (size_t)l * 1024 * D; ldk = 2048; Nsrc = D; WT = (bf16*)(wsw + WS_WOA); kb = r / 32; nb = r % 32; }
    else if ((r -= CV_OA) < CV_OA) { W = w_ob + (size_t)l * 1024 * D; ldk = 2048; Nsrc = D; WT = (bf16*)(wsw + WS_WOB); kb = r / 32; nb = r % 32; }
    else if ((r -= CV_OA) < CV_OUT) { W = w_out + (size_t)l * D * D; ldk = D; Nsrc = D; WT = (bf16*)(wsw + WS_WOUT); kb = r / 32; nb = r % 32; }
    else if ((r -= CV_OUT) < CV_UP) { W = w_up + (size_t)l * D * NUP; ldk = D; Nsrc = NUP; WT = (bf16*)(wsw + WS_WUP); kb = r / (NUP / 64); nb = r % (NUP / 64); map = 2; gain = ln2 + (size_t)l * D; }
    else { r -= CV_UP; W = w_dn + (size_t)l * DFF * D; ldk = DFF; Nsrc = D; WT = (bf16*)(wsw + WS_WDN); kb = r / 32; nb = r % 32; }
    const int k0 = 64 * kb, n0 = 64 * nb, c = lane & 15, kr2 = lane >> 4, nd0 = n0 + 4 * c;
    const int ns = map == 1 ? win_src_col(nd0) : (map == 2 ? (((nd0 & 255) < 128) ? 128 * (nd0 >> 8) + (nd0 & 255) : DFF + 128 * (nd0 >> 8) + (nd0 & 255) - 128) : nd0);
    CvItem I; I.wp = W + (size_t)(k0 + 2 * kr2) * Nsrc + (ns >= 0 ? ns : 0); I.gp = gain ? gain + k0 + 2 * kr2 : nullptr; I.op = WT + (size_t)(n0 + (lane >> 3)) * ldk + k0 + 8 * (lane & 7);
    I.Nsrc = Nsrc; I.ldk = ldk; I.valid = ns >= 0; return I;
}
__device__ __forceinline__ void cvt_load(const CvItem& I, f32x4 (&va)[8], f32x4 (&vb)[8]) {
#pragma unroll
    for (int kk = 0; kk < 8; ++kk) { va[kk] = (f32x4){0.f, 0.f, 0.f, 0.f}; vb[kk] = va[kk];
        if (I.valid) { va[kk] = __builtin_nontemporal_load((const f32x4*)(I.wp + (size_t)(8 * kk) * I.Nsrc)); vb[kk] = __builtin_nontemporal_load((const f32x4*)(I.wp + (size_t)(8 * kk + 1) * I.Nsrc)); } }
}
__device__ __forceinline__ void cvt_process(const CvItem& I, f32x4 (&va)[8], f32x4 (&vb)[8], LAS unsigned* T, int lane) {
    const int c = lane & 15, kr2 = lane >> 4;
#pragma unroll
    for (int kk = 0; kk < 8; ++kk) {
        f32x4 a = va[kk], b = vb[kk];
        if (I.gp) { a *= I.gp[8 * kk]; b *= I.gp[8 * kk + 1]; }
        T[(4 * c + 0) * 33 + 4 * kk + kr2] = pk2(a[0], b[0]); T[(4 * c + 1) * 33 + 4 * kk + kr2] = pk2(a[1], b[1]);
        T[(4 * c + 2) * 33 + 4 * kk + kr2] = pk2(a[2], b[2]); T[(4 * c + 3) * 33 + 4 * kk + kr2] = pk2(a[3], b[3]);
    }
    LDS_WAIT();
    const int nl = lane >> 3, ch = lane & 7;
#pragma unroll
    for (int j = 0; j < 8; ++j) { const LAS unsigned* tp = T + (8 * j + nl) * 33 + 4 * ch;
        v4u o; o.x = tp[0]; o.y = tp[1]; o.z = tp[2]; o.w = tp[3];
        *(v4u*)(I.op + (size_t)(8 * j) * I.ldk) = o; }
    LDS_WAIT();
}
__device__ __forceinline__ void cvt_range(LAS unsigned char* lds, int it0, int it1, int gw, int NGW, const float* w_in, const float* w_oa, const float* w_ob, const float* w_out, const float* w_up, const float* w_dn, unsigned char* wsw, const float* ln1, const float* ln2) {
    const int lane = ltid() & 63, wave = ltid() >> 6;
    LAS unsigned* scr = (LAS unsigned*)(lds + wave * 8448);
    int it = it0 + gw;
    if (it >= it1) return;
    f32x4 va[8], vb[8], wa[8], wb[8];
    CvItem I = cvt_decode(it, lane, w_in, w_oa, w_ob, w_out, w_up, w_dn, wsw, ln1, ln2);
    cvt_load(I, va, vb);
#pragma unroll 1
    for (;;) {
        const bool m1 = it + NGW < it1; CvItem J = I;
        if (m1) { J = cvt_decode(it + NGW, lane, w_in, w_oa, w_ob, w_out, w_up, w_dn, wsw, ln1, ln2); cvt_load(J, wa, wb); }
        cvt_process(I, va, vb, scr, lane);
        if (!m1) break;
        const bool m2 = it + 2 * NGW < it1;
        if (m2) { I = cvt_decode(it + 2 * NGW, lane, w_in, w_oa, w_ob, w_out, w_up, w_dn, wsw, ln1, ln2); cvt_load(I, va, vb); }
        cvt_process(J, wa, wb, scr, lane);
        if (!m2) break;
        it += 2 * NGW;
    }
}
constexpr int CV_PER_CU = 48;
constexpr int CV_THRU_UP = CV_IN + 2 * CV_OA + CV_OUT + CV_UP;
struct CvPlan { int X, T1, T2; };
__device__ __forceinline__ CvPlan cvt_plan(int G) {
    const int u1 = (MPAD / 256) * (NIN / 256), u2 = (MPAD / 256) * (NUP / 256), idle1 = (u1 % G) ? G - u1 % G : 0, idle2 = (u2 % G) ? G - u2 % G : 0;
    CvPlan p; p.T1 = idle1 * CV_PER_CU; p.T2 = idle2 * CV_PER_CU; p.X = max(CV_IN, CV_THRU_UP - p.T1); return p;
}
__device__ __forceinline__ void phase_bias(const float* rel_bias, float* biasT) {
    for (int idx = lbid() * 512 + ltid(); idx < 2048; idx += gridDim.x * 512) {
        const int h = idx >> 7, d = idx & 127;
        int bk = d;
        if (d >= 16) { const float v = logf((float)d / 16.0f) / 2.0794415416798357f * 16.0f; bk = 16 + (int)v; if (bk > 31) bk = 31; }
        biasT[idx] = rel_bias[bk * 16 + h];
    }
}
__device__ __forceinline__ void phase_first(const float* xp, const float* xs, bf16* XB, float* RS) {
    const int tid_ = ltid(), lane = tid_ & 63, wave = tid_ >> 6;
    const int gw = lbid() * 8 + wave, NGW = gridDim.x * 8;
    for (int row = gw; row < MREAL; row += NGW) {
        const float* xr = row < MP ? xp + (size_t)row * D : xs + (size_t)(row - MP) * D;
        float ss = 0.f;
#pragma unroll
        for (int j = 0; j < 8; ++j) { const f32x4 v = ((const f32x4*)xr)[lane + 64 * j];
            v2u w; w.x = pk2(v.x, v.y); w.y = pk2(v.z, v.w); ((v2u*)(XB + (size_t)row * D))[lane + 64 * j] = w;
            const float r0 = bfl(w.x), r1 = bfh(w.x), r2 = bfl(w.y), r3 = bfh(w.y); ss += (r0 * r0 + r1 * r1) + (r2 * r2 + r3 * r3); }
        ss = wave_sum(ss);
        if (row < MP) { if (lane < 32) RS[(size_t)row * 32 + lane] = lane == 0 ? ss : 0.f; }
        else { float* sp = RS + (size_t)MP * 32 + (size_t)(row - MP) * 128; sp[lane] = lane == 0 ? ss : 0.f; sp[64 + lane] = 0.f; }
    }
}
constexpr int AT_KB = 0, AT_VT = 36864, AT_BT = 72704, AT_PW = 74752;
__device__ __forceinline__ void attn_prompt_unit(LAS unsigned char* lds, int u, int l, const bf16* PROJ, const float* lnq, const float* lnk, const float* sinks, const float* biasT, bf16* OA, float* outK, float* outV) {
    const int tid = ltid(), lane = tid & 63, wave = tid >> 6;
    const int kh = u & 3, nb = (u >> 2) & 31, b = u >> 7;
#pragma unroll
    for (int it = 0; it < 4; ++it) {
        const int idx = it * 512 + tid, j = idx >> 3, ch = idx & 7;
        const int tok = nb * 128 - 128 + j;
        v4u kw = {0u, 0u, 0u, 0u}, vw = {0u, 0u, 0u, 0u};
        if (tok >= 0) { const bf16* rp = PROJ + (size_t)(b * SEQ + tok) * NIN + kh * 64 + ch * 8; kw = *(const v4u*)(rp + C_KA); vw = *(const v4u*)(rp + C_VA); }
        float kf[8] = {bfl(kw.x), bfh(kw.x), bfl(kw.y), bfh(kw.y), bfl(kw.z), bfh(kw.z), bfl(kw.w), bfh(kw.w)};
        float ss = 0.f;
#pragma unroll
        for (int e = 0; e < 8; ++e) ss += kf[e] * kf[e];
        ss = red8_sum(ss);
        const float r = rsqrtf(ss * (1.0f / 64.0f) + EPS);
        const f32x4 g0 = *(const f32x4*)(lnk + l * 64 + ch * 8), g1 = *(const f32x4*)(lnk + l * 64 + ch * 8 + 4);
        kf[0] *= r * g0.x; kf[1] *= r * g0.y; kf[2] *= r * g0.z; kf[3] *= r * g0.w; kf[4] *= r * g1.x; kf[5] *= r * g1.y; kf[6] *= r * g1.z; kf[7] *= r * g1.w;
        v4u ko; ko.x = pk2(kf[0], kf[1]); ko.y = pk2(kf[2], kf[3]); ko.z = pk2(kf[4], kf[5]); ko.w = pk2(kf[6], kf[7]);
        *(LAS v4u*)(lds + AT_KB + j * 144 + ch * 16) = ko;
        const unsigned vv[4] = {vw.x, vw.y, vw.z, vw.w};
#pragma unroll
        for (int e = 0; e < 4; ++e) { *(LAS bf16*)(lds + AT_VT + ((ch * 8 + 2 * e) * 280 + j) * 2) = (bf16)(vv[e] & 0xffffu); *(LAS bf16*)(lds + AT_VT + ((ch * 8 + 2 * e + 1) * 280 + j) * 2) = (bf16)(vv[e] >> 16); }
        if (nb == 31 && j >= 128) {
            float* ok = outK + ((size_t)((l * 2 + b) * 128 + (j - 128))) * 256 + kh * 64 + ch * 8;
            *(f32x4*)ok = (f32x4){kf[0], kf[1], kf[2], kf[3]}; *(f32x4*)(ok + 4) = (f32x4){kf[4], kf[5], kf[6], kf[7]};
            float* ov = outV + ((size_t)((l * 2 + b) * 128 + (j - 128))) * 256 + kh * 64 + ch * 8;
            *(f32x4*)ov = (f32x4){bfl(vw.x), bfh(vw.x), bfl(vw.y), bfh(vw.y)}; *(f32x4*)(ov + 4) = (f32x4){bfl(vw.z), bfh(vw.z), bfl(vw.w), bfh(vw.w)};
        }
    }
    for (int idx = tid; idx < 64 * 24; idx += 512) *(LAS bf16*)(lds + AT_VT + ((idx / 24) * 280 + 256 + idx % 24) * 2) = (bf16)0;
    { const int g = tid >> 7, d = tid & 127; ((LAS float*)(lds + AT_BT))[tid] = biasT[(kh * 4 + g) * 128 + d]; }
    __syncthreads();
    const int g = wave >> 1, qh = wave & 1, hq = kh * 4 + g, lr = lane & 15, lq = lane >> 4;
    const float sink = sinks[l * 16 + hq];
    LAS bf16* Pw = (LAS bf16*)(lds + AT_PW + wave * 5376);
    const LAS float* BT = (const LAS float*)(lds + AT_BT) + g * 128;
    const bf16* qp0 = PROJ + (size_t)(b * SEQ + nb * 128 + 64 * qh + lr) * NIN + C_QA + hq * 64 + 8 * lq;
    v4u qn0 = *(const v4u*)qp0, qn1 = *(const v4u*)(qp0 + 32);
#pragma unroll 2
    for (int mt = 0; mt < 4; ++mt) {
        const int ibase = 64 * qh + 16 * mt, kt0 = 4 * qh + mt;
        const v4u q0 = qn0, q1 = qn1;
        if (mt < 3) { const bf16* qp = qp0 + (size_t)(16 * (mt + 1)) * NIN; qn0 = *(const v4u*)qp; qn1 = *(const v4u*)(qp + 32); }
        float qf[16] = {bfl(q0.x), bfh(q0.x), bfl(q0.y), bfh(q0.y), bfl(q0.z), bfh(q0.z), bfl(q0.w), bfh(q0.w), bfl(q1.x), bfh(q1.x), bfl(q1.y), bfh(q1.y), bfl(q1.z), bfh(q1.z), bfl(q1.w), bfh(q1.w)};
        float ss = 0.f;
#pragma unroll
        for (int e = 0; e < 16; ++e) ss += qf[e] * qf[e];
        ss = xrows_sum(ss);
        const float r = rsqrtf(ss * (1.0f / 64.0f) + EPS) * 0.125f;
        const float* gq = lnq + l * 64 + 8 * lq;
        const f32x4 ga = *(const f32x4*)gq, gb = *(const f32x4*)(gq + 4), gc = *(const f32x4*)(gq + 32), gd = *(const f32x4*)(gq + 36);
        v4u qa, qb;
        qa.x = pk2(qf[0] * r * ga.x, qf[1] * r * ga.y); qa.y = pk2(qf[2] * r * ga.z, qf[3] * r * ga.w); qa.z = pk2(qf[4] * r * gb.x, qf[5] * r * gb.y); qa.w = pk2(qf[6] * r * gb.z, qf[7] * r * gb.w);
        qb.x = pk2(qf[8] * r * gc.x, qf[9] * r * gc.y); qb.y = pk2(qf[10] * r * gc.z, qf[11] * r * gc.w); qb.z = pk2(qf[12] * r * gd.x, qf[13] * r * gd.y); qb.w = pk2(qf[14] * r * gd.z, qf[15] * r * gd.w);
        f32x4 s[9];
#pragma unroll
        for (int nt = 0; nt < 9; ++nt) {
            const LAS v4u* kp = (const LAS v4u*)(lds + AT_KB + ((kt0 + nt) * 16 + lr) * 144 + lq * 16);
            f32x4 a = {0.f, 0.f, 0.f, 0.f};
            a = __builtin_amdgcn_mfma_f32_16x16x32_bf16(as_frag(kp[0]), as_frag(qa), a, 0, 0, 0);
            a = __builtin_amdgcn_mfma_f32_16x16x32_bf16(as_frag(kp[4]), as_frag(qb), a, 0, 0, 0);
            s[nt] = a;
        }
        const int i = ibase + lr;
        float mx = -INFINITY;
#pragma unroll
        for (int nt = 0; nt < 9; ++nt)
#pragma unroll
            for (int rr = 0; rr < 4; ++rr) {
                const int j = (kt0 + nt) * 16 + 4 * lq + rr, dd = i + 128 - j;
                const bool ok = dd >= 0 && dd < 128 && (nb > 0 || j >= 128);
                const float sv = (s[nt][rr] + BT[dd & 127]) + (ok ? 0.f : -INFINITY);
                s[nt][rr] = sv; mx = fmaxf(mx, sv);
            }
        mx = fmaxf(xrows_max(mx), sink);
        float sum = 0.f;
#pragma unroll
        for (int nt = 0; nt < 9; ++nt)
#pragma unroll
            for (int rr = 0; rr < 4; ++rr) { const float p = __expf(s[nt][rr] - mx); s[nt][rr] = p; sum += p; }
        sum = xrows_sum(sum) + __expf(sink - mx);
        const float inv = __builtin_amdgcn_rcpf(sum);
        v2u pk[10];
#pragma unroll
        for (int nt = 0; nt < 9; ++nt) { pk[nt].x = pk2(s[nt][0], s[nt][1]); pk[nt].y = pk2(s[nt][2], s[nt][3]); }
        pk[9].x = 0u; pk[9].y = 0u;
        f32x4 o[4];
#pragma unroll
        for (int dt = 0; dt < 4; ++dt) o[dt] = (f32x4){0.f, 0.f, 0.f, 0.f};
#pragma unroll
        for (int ks = 0; ks < 5; ++ks) {
            v4u pf; pf.x = pk[2 * ks].x; pf.y = pk[2 * ks].y; pf.z = pk[2 * ks + 1].x; pf.w = pk[2 * ks + 1].y;
#pragma unroll
            for (int dt = 0; dt < 4; ++dt) {
                const LAS unsigned char* vb = lds + AT_VT + ((16 * dt + lr) * 280 + kt0 * 16 + 32 * ks + 4 * lq) * 2;
                const v2u lo = *(const LAS v2u*)vb, hi = *(const LAS v2u*)(vb + 32);
                v4u vf; vf.x = lo.x; vf.y = lo.y; vf.z = hi.x; vf.w = hi.y;
                o[dt] = __builtin_amdgcn_mfma_f32_16x16x32_bf16(as_frag(vf), as_frag(pf), o[dt], 0, 0, 0);
            }
        }
#pragma unroll
        for (int dt = 0; dt < 4; ++dt)
            { v2u w; w.x = pk2(o[dt][0] * inv, o[dt][1] * inv); w.y = pk2(o[dt][2] * inv, o[dt][3] * inv); *(v2u*)(OA + (size_t)(b * SEQ + nb * 128 + ibase + lr) * 2048 + hq * 64 + 16 * dt + 4 * lq) = w; }
    }
    __syncthreads();
}
constexpr int AS_K = 0, AS_V = 34320, AS_Q = 68112, AS_P = 70160;
__device__ __forceinline__ void attn_sample_unit(LAS unsigned char* lds, int u, int l, const bf16* PROJ, const float* cache_k, const float* cache_v, const float* lnq, const float* lnk, const float* sinks,
                                                 const float* biasT, bf16* OA, float* outK, float* outV) {
    const int tid = ltid(), lane = tid & 63, wave = tid >> 6;
    const int kh = u & 3, b = u >> 2;
    LAS float* KS = (LAS float*)(lds + AS_K); LAS float* VS = (LAS float*)(lds + AS_V);
    {
        const int d = tid & 63, jb = tid >> 6;
        const float* ckp = cache_k + ((size_t)((l * 32 + b) * 128)) * 256 + kh * 64 + d; const float* cvp = cache_v + ((size_t)((l * 32 + b) * 128)) * 256 + kh * 64 + d;
        float* okp = outK + ((size_t)((l * 32 + b) * 128)) * 256 + kh * 64 + d; float* ovp = outV + ((size_t)((l * 32 + b) * 128)) * 256 + kh * 64 + d;
        float kk[16], vv[16];
#pragma unroll
        for (int i = 0; i < 16; ++i) { const int j = jb + 8 * i; kk[i] = ckp[(size_t)j * 256]; vv[i] = cvp[(size_t)j * 256]; }
#pragma unroll
        for (int i = 0; i < 16; ++i) { const int j = jb + 8 * i; KS[j * 65 + d] = kk[i]; VS[j * 64 + d] = vv[i];
            if (j >= 4) { okp[(size_t)(j - 4) * 256] = kk[i]; ovp[(size_t)(j - 4) * 256] = vv[i]; } }
        if (jb < 4) {
            const int j = 128 + jb; const bf16* rp = PROJ + (size_t)(MP + b * 4 + jb) * NIN + kh * 64 + d; float kv = bf1(rp[C_KA]); const float v1 = bf1(rp[C_VA]);
            const float ss = wave_sum(kv * kv); kv = kv * rsqrtf(ss * (1.0f / 64.0f) + EPS) * lnk[l * 64 + d];
            KS[j * 65 + d] = kv; VS[j * 64 + d] = v1; okp[(size_t)(j - 4) * 256] = kv; ovp[(size_t)(j - 4) * 256] = v1; }
    }
    __syncthreads();
    LAS float* QS = (LAS float*)(lds + AS_Q) + wave * 64; LAS float* PS = (LAS float*)(lds + AS_P) + wave * 136;
#pragma unroll 1
    for (int s2 = 0; s2 < 2; ++s2) {
        const int rr = 2 * wave + s2, tt = rr & 3, g = rr >> 2, hq = kh * 4 + g;
        const size_t row = (size_t)(MP + b * 4 + tt);
        float q = bf1(PROJ[row * NIN + C_QA + hq * 64 + lane]);
        const float ss = wave_sum(q * q);
        q = q * rsqrtf(ss * (1.0f / 64.0f) + EPS) * lnq[l * 64 + lane] * 0.125f;
        QS[lane] = q; LDS_WAIT();
        const float sink = sinks[l * 16 + hq];
        float sc[3]; float m = sink;
#pragma unroll
        for (int c = 0; c < 3; ++c) {
            const int j = lane + 64 * c; float a = -INFINITY;
            if (j < 132) { const int dd = tt + 128 - j;
                if (dd >= 0 && dd < 128) { a = 0.f;
#pragma unroll 8
                    for (int d = 0; d < 64; ++d) a += QS[d] * KS[j * 65 + d];
                    a += biasT[hq * 128 + dd]; } }
            sc[c] = a; m = fmaxf(m, a);
        }
        m = wave_max(m);
        float sum = 0.f;
#pragma unroll
        for (int c = 0; c < 3; ++c) { const float p = __expf(sc[c] - m); sum += p; const int j = lane + 64 * c; if (j < 132) PS[j] = p; }
        sum = wave_sum(sum) + __expf(sink - m);
        LDS_WAIT();
        float o = 0.f;
#pragma unroll 4
        for (int j = 0; j < 132; ++j) o += PS[j] * VS[j * 64 + lane];
        OA[row * 2048 + hq * 64 + lane] = f2bf(o * __builtin_amdgcn_rcpf(sum));
        LDS_WAIT();
    }
    __syncthreads();
}
constexpr int GL_AL = 0, GL_KK = 8192, GL_QQ = 16384, GL_VV = 24576, GL_OB = 40960, GL_GS = 73728;
template <bool OUTC>
__device__ __forceinline__ void gla_unit(LAS unsigned char* lds, int l, int h, size_t rowbase, int ntok, const bf16* PROJ, const float* GK, const float* w_gk2, const float* b_gk, const float* ln_o,
                                         const float* Sin, float* Sout, float* DLout, bf16* OB) {
    const int tid = ltid(), lane = tid & 63, wave = tid >> 6;
    const int e = tid & 255, dh = tid >> 8, d = tid & 127, tg = tid >> 7;
    LAS float* AL = (LAS float*)(lds + GL_AL); LAS float* KK = (LAS float*)(lds + GL_KK); LAS float* QQ = (LAS float*)(lds + GL_QQ); LAS float* VV = (LAS float*)(lds + GL_VV);
    LAS float* OBF = (LAS float*)(lds + GL_OB); LAS float* GS = (LAS float*)(lds + GL_GS);
    float wg[16];
#pragma unroll
    for (int r = 0; r < 16; ++r) wg[r] = w_gk2[((size_t)l * 16 + r) * 512 + h * 128 + d];
    const float bg = b_gk[l * 512 + h * 128 + d];
    float S[64];
#pragma unroll
    for (int i = 0; i < 64; ++i) S[i] = OUTC ? Sin[(size_t)(dh * 64 + i) * 256 + e] : 0.f;
    float gacc = 0.f;
#pragma unroll 1
    for (int t0 = 0; t0 < ntok; t0 += 16) {
        const int nts = (ntok - t0) < 16 ? (ntok - t0) : 16;
#pragma unroll 1
        for (int i = 0; i < 4; ++i) {
            const int tt = tg * 4 + i;
            if (tt < nts) {
                const size_t row = rowbase + t0 + tt;
                const f32x4 k0 = *(const f32x4*)(GK + row * 16), k1 = *(const f32x4*)(GK + row * 16 + 4), k2 = *(const f32x4*)(GK + row * 16 + 8), k3 = *(const f32x4*)(GK + row * 16 + 12);
                float x = bg;
                x += k0.x * wg[0] + k0.y * wg[1] + k0.z * wg[2] + k0.w * wg[3]; x += k1.x * wg[4] + k1.y * wg[5] + k1.z * wg[6] + k1.w * wg[7];
                x += k2.x * wg[8] + k2.y * wg[9] + k2.z * wg[10] + k2.w * wg[11]; x += k3.x * wg[12] + k3.y * wg[13] + k3.z * wg[14] + k3.w * wg[15];
                const float gg = logsig(x) * (1.0f / 16.0f);
                gacc += gg;
                AL[tt * 128 + d] = __expf(gg);
                KK[tt * 128 + d] = bf1(PROJ[row * NIN + C_KB + h * 128 + d]);
                if (OUTC) QQ[tt * 128 + d] = bf1(PROJ[row * NIN + C_QB + h * 128 + d]) * 0.08838834764831845f;
            }
        }
        { const int tt = tid >> 5, e0 = (tid & 31) * 8;
          if (tt < nts) { const v4u w = *(const v4u*)(PROJ + (rowbase + t0 + tt) * NIN + C_VB + h * 256 + e0);
              *(LAS f32x4*)(VV + tt * 256 + e0) = (f32x4){bfl(w.x), bfh(w.x), bfl(w.y), bfh(w.y)}; *(LAS f32x4*)(VV + tt * 256 + e0 + 4) = (f32x4){bfl(w.z), bfh(w.z), bfl(w.w), bfh(w.w)}; } }
        __syncthreads();
#pragma unroll 1
        for (int tt = 0; tt < nts; ++tt) {
            const float ve = VV[tt * 256 + e];
            float o = 0.f;
#pragma unroll
            for (int q4 = 0; q4 < 16; ++q4) {
                const f32x4 a4 = *(const LAS f32x4*)(AL + tt * 128 + dh * 64 + 4 * q4), k4 = *(const LAS f32x4*)(KK + tt * 128 + dh * 64 + 4 * q4);
                S[4 * q4 + 0] = a4.x * S[4 * q4 + 0] + k4.x * ve; S[4 * q4 + 1] = a4.y * S[4 * q4 + 1] + k4.y * ve;
                S[4 * q4 + 2] = a4.z * S[4 * q4 + 2] + k4.z * ve; S[4 * q4 + 3] = a4.w * S[4 * q4 + 3] + k4.w * ve;
                if (OUTC) { const f32x4 c4 = *(const LAS f32x4*)(QQ + tt * 128 + dh * 64 + 4 * q4);
                    o += c4.x * S[4 * q4 + 0] + c4.y * S[4 * q4 + 1] + c4.z * S[4 * q4 + 2] + c4.w * S[4 * q4 + 3]; }
            }
            if (OUTC) OBF[(dh * 16 + tt) * 256 + e] = o;
        }
        __syncthreads();
        if (OUTC) {
#pragma unroll 1
            for (int s2 = 0; s2 < 2; ++s2) {
                const int tt = 2 * wave + s2;
                if (tt < nts) {
                    const size_t row = rowbase + t0 + tt;
                    const f32x4 oa = *(const LAS f32x4*)(OBF + tt * 256 + 4 * lane), ob = *(const LAS f32x4*)(OBF + (16 + tt) * 256 + 4 * lane);
                    const f32x4 o4 = oa + ob;
                    const float ss = wave_sum((o4.x * o4.x + o4.y * o4.y) + (o4.z * o4.z + o4.w * o4.w));
                    const float r = rsqrtf(ss * (1.0f / 256.0f) + EPS);
                    const f32x4 gn = *(const f32x4*)(ln_o + l * 256 + 4 * lane);
                    const v2u rw = *(const v2u*)(PROJ + row * NIN + C_RB + h * 256 + 4 * lane);
                    const float r0 = bfl(rw.x), r1 = bfh(rw.x), r2 = bfl(rw.y), r3 = bfh(rw.y);
                    v2u w; w.x = pk2(o4.x * r * gn.x * r0 * sigm(r0), o4.y * r * gn.y * r1 * sigm(r1)); w.y = pk2(o4.z * r * gn.z * r2 * sigm(r2), o4.w * r * gn.w * r3 * sigm(r3));
                    *(v2u*)(OB + row * 2048 + h * 256 + 4 * lane) = w;
                }
            }
            __syncthreads();
        }
    }
    if (Sout) {
#pragma unroll
        for (int i = 0; i < 64; ++i) Sout[(size_t)(dh * 64 + i) * 256 + e] = S[i];
    }
    if (!OUTC) {
        GS[tg * 128 + d] = gacc;
        __syncthreads();
        if (tid < 128) DLout[tid] = __expf(GS[tid] + GS[128 + tid] + GS[256 + tid] + GS[384 + tid]);
        __syncthreads();
    }
}
constexpr int GA_GK = 0, GA_TOT = 8192, GA_DL = 10240, GA_KT = 12288, GA_VT = 47104;
constexpr int GC_QL = 0, GC_KL = 34816, GC_VT = 69632;
__device__ __forceinline__ void gla_stage_vt(LAS unsigned char* vt, const bf16* vsrc  , int lane) {
#pragma unroll
    for (int it = 0; it < 8; ++it) {
        const int tok = it * 16 + (lane >> 2), ch = lane & 3;
        const v4u w = *(const v4u*)(vsrc + (size_t)tok * NIN + ch * 8);
        const unsigned ww[4] = {w.x, w.y, w.z, w.w};
#pragma unroll
        for (int e = 0; e < 4; ++e) { *(LAS bf16*)(vt + ((ch * 8 + 2 * e) * 136 + tok) * 2) = (bf16)(ww[e] & 0xffffu); *(LAS bf16*)(vt + ((ch * 8 + 2 * e + 1) * 136 + tok) * 2) = (bf16)(ww[e] >> 16); }
    }
}
__device__ __forceinline__ void gla_a_unit(LAS unsigned char* lds, int l, int h, size_t rowbase, const bf16* PROJ, const float* GK, const float* w_gk2, const float* b_gk, bf16* QT, bf16* KT, float* UT, float* DLout) {
    const int tid = ltid(), lane = tid & 63, wave = tid >> 6, d = tid & 127, seg = tid >> 7, lr = lane & 15, g = lane >> 4;
    LAS float* GKL = (LAS float*)(lds + GA_GK); LAS float* TOT = (LAS float*)(lds + GA_TOT); LAS float* DLL = (LAS float*)(lds + GA_DL);
    LAS unsigned char* KTL = lds + GA_KT; LAS unsigned char* VTW = lds + GA_VT + wave * 8704;
    *(LAS f32x4*)(GKL + tid * 4) = *(const f32x4*)(GK + rowbase * 16 + tid * 4);
    gla_stage_vt(VTW, PROJ + rowbase * NIN + C_VB + h * 256 + 32 * wave, lane);
    bf16 kraw[32], qraw[32];
#pragma unroll
    for (int ti = 0; ti < 32; ++ti) { const bf16* pp = PROJ + (rowbase + seg * 32 + ti) * NIN + h * 128 + d; kraw[ti] = pp[C_KB]; qraw[ti] = pp[C_QB]; }
    float wg[16];
#pragma unroll
    for (int r = 0; r < 16; ++r) wg[r] = w_gk2[((size_t)l * 16 + r) * 512 + h * 128 + d];
    const float bg = b_gk[l * 512 + h * 128 + d];
    __syncthreads();
    float gv[32]; float run = 0.f;
#pragma unroll
    for (int i = 0; i < 32; ++i) {
        const LAS f32x4* gp = (const LAS f32x4*)(GKL + (seg * 32 + i) * 16);
        const f32x4 k0 = gp[0], k1 = gp[1], k2 = gp[2], k3 = gp[3];
        float x = bg;
        x += k0.x * wg[0] + k0.y * wg[1] + k0.z * wg[2] + k0.w * wg[3]; x += k1.x * wg[4] + k1.y * wg[5] + k1.z * wg[6] + k1.w * wg[7];
        x += k2.x * wg[8] + k2.y * wg[9] + k2.z * wg[10] + k2.w * wg[11]; x += k3.x * wg[12] + k3.y * wg[13] + k3.z * wg[14] + k3.w * wg[15];
        run += logsig(x) * (1.0f / 16.0f); gv[i] = run;
    }
    TOT[seg * 128 + d] = run;
    __syncthreads();
    const float t0 = TOT[d], t1 = TOT[128 + d], t2 = TOT[256 + d], t3 = TOT[384 + d];
    const float off = seg == 0 ? 0.f : (seg == 1 ? t0 : (seg == 2 ? t0 + t1 : t0 + t1 + t2));
    if (seg == 0) { const float pd = __expf(((t0 + t1) + t2) + t3); DLL[d] = pd; DLout[d] = pd; }
    const size_t prow = rowbase + seg * 32;
#pragma unroll
    for (int i8 = 0; i8 < 4; ++i8) {
        float kt[8];
#pragma unroll
        for (int i = 0; i < 8; ++i) {
            const int ti = i8 * 8 + i; const float bb = off + gv[ti];
            const float kq = bf1(kraw[ti]), qq = bf1(qraw[ti]);
            kt[i] = kq * __expf(-bb);
            const float qt = qq * 0.08838834764831845f * __expf(bb);
            KT[(prow + ti) * 512 + h * 128 + d] = f2bf(kt[i]); QT[(prow + ti) * 512 + h * 128 + d] = f2bf(qt);
        }
        v4u w; w.x = pk2(kt[0], kt[1]); w.y = pk2(kt[2], kt[3]); w.z = pk2(kt[4], kt[5]); w.w = pk2(kt[6], kt[7]);
        *(LAS v4u*)(KTL + d * 272 + (seg * 32 + i8 * 8) * 2) = w;
    }
    __syncthreads();
    f32x4 acc[2][8];
#pragma unroll
    for (int mt = 0; mt < 2; ++mt)
#pragma unroll
        for (int nt = 0; nt < 8; ++nt) acc[mt][nt] = (f32x4){0.f, 0.f, 0.f, 0.f};
#pragma unroll
    for (int ks = 0; ks < 4; ++ks) {
        const v4u a0 = *(const LAS v4u*)(VTW + lr * 272 + (32 * ks + 8 * g) * 2), a1 = *(const LAS v4u*)(VTW + (16 + lr) * 272 + (32 * ks + 8 * g) * 2);
#pragma unroll
        for (int nt = 0; nt < 8; ++nt) {
            const v4u bf = *(const LAS v4u*)(KTL + (16 * nt + lr) * 272 + (32 * ks + 8 * g) * 2);
            acc[0][nt] = __builtin_amdgcn_mfma_f32_16x16x32_bf16(as_frag(bf), as_frag(a0), acc[0][nt], 0, 0, 0);
            acc[1][nt] = __builtin_amdgcn_mfma_f32_16x16x32_bf16(as_frag(bf), as_frag(a1), acc[1][nt], 0, 0, 0);
        }
    }
#pragma unroll
    for (int nt = 0; nt < 8; ++nt) { const f32x4 dl = *(const LAS f32x4*)(DLL + 16 * nt + 4 * g);
#pragma unroll
        for (int mt = 0; mt < 2; ++mt) *(f32x4*)(UT + (size_t)(32 * wave + 16 * mt + lr) * 128 + 16 * nt + 4 * g) = acc[mt][nt] * dl; }
    __syncthreads();
}
__device__ __forceinline__ void gla_scan2(int l, const float* GU, const float* GDL, bf16* GS, float* outG) {
    for (int blk = lbid(); blk < 8 * 256 * 64 / 512; blk += gridDim.x) {
        const int bh = blk >> 5; const unsigned rem = (unsigned)((blk & 31) * 512 + ltid()), e = rem >> 6, d2 = (rem & 63u) * 2u;
        const unsigned vo = e * 128u + d2;
        const float* gu = GU + (size_t)bh * NCH * 32768; const float* gd = GDL + (size_t)bh * NCH * 128; bf16* gs = GS + (size_t)bh * NCH * 32768;
        float s0 = 0.f, s1 = 0.f;
        float2 uu[NCH], dl[NCH];
#pragma unroll
        for (int i = 0; i < NCH; ++i) { uu[i] = *(const float2*)(gu + (size_t)i * 32768 + vo); dl[i] = *(const float2*)(gd + i * 128 + d2); }
#pragma unroll
        for (int i = 0; i < NCH; ++i) { *(unsigned*)(gs + (size_t)i * 32768 + vo) = pk2(s0, s1); s0 = dl[i].x * s0 + uu[i].x; s1 = dl[i].y * s1 + uu[i].y; }
        float* op = outG + ((size_t)(l * 8 + bh)) * 32768 + (size_t)d2 * 256 + e;
        op[0] = s0; op[256] = s1;
    }
}
__device__ __forceinline__ void gla_c_unit(LAS unsigned char* lds, int l, int h, size_t rowbase, const bf16* PROJ, const bf16* QT, const bf16* KT, const bf16* ST, const float* ln_o, bf16* OB) {
    const int tid = ltid(), lane = tid & 63, wave = tid >> 6, lr = lane & 15, g = lane >> 4;
    LAS unsigned char* QL = lds + GC_QL; LAS unsigned char* KL = lds + GC_KL; LAS unsigned char* VTW = lds + GC_VT + wave * 8704;
#pragma unroll
    for (int it = 0; it < 4; ++it) { const int idx = it * 512 + tid, row = idx >> 4, ch = idx & 15;
        *(LAS v4u*)(QL + row * 272 + ch * 16) = *(const v4u*)(QT + (rowbase + row) * 512 + h * 128 + ch * 8);
        *(LAS v4u*)(KL + row * 272 + ch * 16) = *(const v4u*)(KT + (rowbase + row) * 512 + h * 128 + ch * 8); }
    gla_stage_vt(VTW, PROJ + rowbase * NIN + C_VB + h * 256 + 32 * wave, lane);
    v4u sA[2][4];
#pragma unroll
    for (int mt = 0; mt < 2; ++mt)
#pragma unroll
        for (int ks = 0; ks < 4; ++ks) sA[mt][ks] = *(const v4u*)(ST + (size_t)(32 * wave + 16 * mt + lr) * 128 + 32 * ks + 8 * g);
    __syncthreads();
    v2u pkt[5];
#pragma unroll
    for (int k = 0; k < 5; ++k) {
        const int t = __builtin_amdgcn_readfirstlane(wave + 8 * k);
        pkt[k].x = 0u; pkt[k].y = 0u;
        if (t < 36) {
            const int mi = (t >= 1) + (t >= 3) + (t >= 6) + (t >= 10) + (t >= 15) + (t >= 21) + (t >= 28), nj = t - ((mi * (mi + 1)) >> 1);
            f32x4 pt = {0.f, 0.f, 0.f, 0.f};
#pragma unroll
            for (int ks = 0; ks < 4; ++ks) { const v4u kA = *(const LAS v4u*)(KL + (16 * nj + lr) * 272 + (32 * ks + 8 * g) * 2), qq = *(const LAS v4u*)(QL + (16 * mi + lr) * 272 + (32 * ks + 8 * g) * 2);
                pt = __builtin_amdgcn_mfma_f32_16x16x32_bf16(as_frag(kA), as_frag(qq), pt, 0, 0, 0); }
            if (nj == mi) {
#pragma unroll
                for (int r = 0; r < 4; ++r) pt[r] = (4 * g + r <= lr) ? pt[r] : 0.f;
            }
            pkt[k].x = pk2(pt[0], pt[1]); pkt[k].y = pk2(pt[2], pt[3]);
        }
    }
    __syncthreads();
#pragma unroll
    for (int k = 0; k < 5; ++k) {
        const int t = __builtin_amdgcn_readfirstlane(wave + 8 * k);
        int mi, nj;
        if (t < 36) { mi = (t >= 1) + (t >= 3) + (t >= 6) + (t >= 10) + (t >= 15) + (t >= 21) + (t >= 28); nj = t - ((mi * (mi + 1)) >> 1); } else { mi = 2 * (t - 36); nj = mi + 1; }
        *(LAS v2u*)(KL + (16 * mi + lr) * 272 + (16 * nj + 4 * g) * 2) = pkt[k];
    }
    __syncthreads();
    f32x4 acc[2][8];
#pragma unroll
    for (int mi = 0; mi < 8; ++mi) {
        v4u qB[4];
#pragma unroll
        for (int ks = 0; ks < 4; ++ks) qB[ks] = *(const LAS v4u*)(QL + (16 * mi + lr) * 272 + (32 * ks + 8 * g) * 2);
        f32x4 a0 = {0.f, 0.f, 0.f, 0.f}, a1 = {0.f, 0.f, 0.f, 0.f};
#pragma unroll
        for (int kj = 0; kj < 4; ++kj) {
            if (2 * kj <= mi) {
                const v4u pf = *(const LAS v4u*)(KL + (16 * mi + lr) * 272 + (32 * kj + 8 * g) * 2);
                const v4u f0 = *(const LAS v4u*)(VTW + lr * 272 + (32 * kj + 8 * g) * 2), f1 = *(const LAS v4u*)(VTW + (16 + lr) * 272 + (32 * kj + 8 * g) * 2);
                a0 = __builtin_amdgcn_mfma_f32_16x16x32_bf16(as_frag(f0), as_frag(pf), a0, 0, 0, 0);
                a1 = __builtin_amdgcn_mfma_f32_16x16x32_bf16(as_frag(f1), as_frag(pf), a1, 0, 0, 0);
            }
        }
#pragma unroll
        for (int ks = 0; ks < 4; ++ks) {
            a0 = __builtin_amdgcn_mfma_f32_16x16x32_bf16(as_frag(sA[0][ks]), as_frag(qB[ks]), a0, 0, 0, 0);
            a1 = __builtin_amdgcn_mfma_f32_16x16x32_bf16(as_frag(sA[1][ks]), as_frag(qB[ks]), a1, 0, 0, 0);
        }
        acc[0][mi] = a0; acc[1][mi] = a1;
    }
    v2u rbv[16];
#pragma unroll
    for (int t = 0; t < 16; ++t) rbv[t] = *(const v2u*)(PROJ + (rowbase + wave * 16 + t) * NIN + C_RB + h * 256 + 4 * lane);
    __syncthreads();
    LAS float* OL = (LAS float*)lds;
#pragma unroll
    for (int mi = 0; mi < 8; ++mi)
#pragma unroll
        for (int mt = 0; mt < 2; ++mt) *(LAS f32x4*)(OL + (16 * mi + lr) * 260 + 32 * wave + 16 * mt + 4 * g) = acc[mt][mi];
    __syncthreads();
    const f32x4 gn = *(const f32x4*)(ln_o + l * 256 + 4 * lane);
#pragma unroll
    for (int t = 0; t < 16; ++t) {
        const int tok = wave * 16 + t; const size_t row = rowbase + tok;
        const f32x4 o4 = *(const LAS f32x4*)(OL + tok * 260 + 4 * lane);
        const float ss = wave_sum((o4.x * o4.x + o4.y * o4.y) + (o4.z * o4.z + o4.w * o4.w));
        const float r = rsqrtf(ss * (1.0f / 256.0f) + EPS);
        const v2u rw = rbv[t];
        const float r0 = bfl(rw.x), r1 = bfh(rw.x), r2 = bfl(rw.y), r3 = bfh(rw.y);
        v2u w; w.x = pk2(o4.x * r * gn.x * r0 * sigm(r0), o4.y * r * gn.y * r1 * sigm(r1)); w.y = pk2(o4.z * r * gn.z * r2 * sigm(r2), o4.w * r * gn.w * r3 * sigm(r3));
        *(v2u*)(OB + row * 2048 + h * 256 + 4 * lane) = w;
    }
    __syncthreads();
}
__device__ __forceinline__ void gla_scan(int l, float* GU, const float* GDL, float* outG) {
    for (int idx = lbid() * 512 + ltid(); idx < 8 * 32768; idx += gridDim.x * 512) {
        const int bh = idx >> 15, de = idx & 32767, d = de >> 8;
        float S = 0.f;
#pragma unroll 1
        for (int c0 = 0; c0 < NCH; c0 += 8) {
            float uu[8], dl[8];
#pragma unroll
            for (int i = 0; i < 8; ++i) { uu[i] = GU[((size_t)(bh * NCH + c0 + i)) * 32768 + de]; dl[i] = GDL[(bh * NCH + c0 + i) * 128 + d]; }
#pragma unroll
            for (int i = 0; i < 8; ++i) { GU[((size_t)(bh * NCH + c0 + i)) * 32768 + de] = S; S = dl[i] * S + uu[i]; }
        }
        outG[((size_t)(l * 8 + bh)) * 32768 + de] = S;
    }
}
__device__ __forceinline__ float gelu_tanh(float x) { const float z = 1.5957691216057308f * (x + 0.044715f * x * x * x); return x * __builtin_amdgcn_rcpf(1.0f + __expf(-z)); }
__device__ __forceinline__ void phase_conv(int l, const bf16* U, const float* state_conv, const float* w_conv, const float* b_conv, bf16* ACT, float* outCP, float* outCS, int seg0, int nseg) {
    constexpr int NCG = DFF / 8;
    const int per = (nseg * NCG + (int)gridDim.x - 1) / (int)gridDim.x;
    for (int k = ltid() - 256; k >= 0 && k < per; k += 256) {
        const int idx = lbid() * per + k; if (idx >= nseg * NCG) break;
        const int seg = seg0 + idx / NCG, cg = idx % NCG, j0 = cg * 8;
        float wv[3][8], wgt[3][8], bv[8], bgt[8];
#pragma unroll
        for (int i = 0; i < 3; ++i) { const float* wp = w_conv + ((size_t)l * 3 + i) * NUP + j0;
            const f32x4 a = *(const f32x4*)wp, b4 = *(const f32x4*)(wp + 4), c = *(const f32x4*)(wp + DFF), d4 = *(const f32x4*)(wp + DFF + 4);
            wv[i][0] = a.x; wv[i][1] = a.y; wv[i][2] = a.z; wv[i][3] = a.w; wv[i][4] = b4.x; wv[i][5] = b4.y; wv[i][6] = b4.z; wv[i][7] = b4.w;
            wgt[i][0] = c.x; wgt[i][1] = c.y; wgt[i][2] = c.z; wgt[i][3] = c.w; wgt[i][4] = d4.x; wgt[i][5] = d4.y; wgt[i][6] = d4.z; wgt[i][7] = d4.w; }
        { const float* bp = b_conv + (size_t)l * NUP + j0; const f32x4 a = *(const f32x4*)bp, b4 = *(const f32x4*)(bp + 4), c = *(const f32x4*)(bp + DFF), d4 = *(const f32x4*)(bp + DFF + 4);
            bv[0] = a.x; bv[1] = a.y; bv[2] = a.z; bv[3] = a.w; bv[4] = b4.x; bv[5] = b4.y; bv[6] = b4.z; bv[7] = b4.w;
            bgt[0] = c.x; bgt[1] = c.y; bgt[2] = c.z; bgt[3] = c.w; bgt[4] = d4.x; bgt[5] = d4.y; bgt[6] = d4.z; bgt[7] = d4.w; }
        float p2v[8], p1v[8], p2g[8], p1g[8];
        size_t rowb; int ntok; float* outp = nullptr; int out_t0 = 0;
        if (seg < 256) {
            const int b = seg >> 7, t0 = (seg & 127) * 32; rowb = (size_t)b * SEQ + t0; ntok = 32;
            if (t0 == 0) {
#pragma unroll
                for (int e = 0; e < 8; ++e) { p2v[e] = 0.f; p1v[e] = 0.f; p2g[e] = 0.f; p1g[e] = 0.f; }
            } else {
                const v4u a = *(const v4u*)(U + (rowb - 2) * NUP + j0), b4 = *(const v4u*)(U + (rowb - 2) * NUP + DFF + j0), c = *(const v4u*)(U + (rowb - 1) * NUP + j0), d4 = *(const v4u*)(U + (rowb - 1) * NUP + DFF + j0);
                p2v[0] = bfl(a.x); p2v[1] = bfh(a.x); p2v[2] = bfl(a.y); p2v[3] = bfh(a.y); p2v[4] = bfl(a.z); p2v[5] = bfh(a.z); p2v[6] = bfl(a.w); p2v[7] = bfh(a.w);
                p2g[0] = bfl(b4.x); p2g[1] = bfh(b4.x); p2g[2] = bfl(b4.y); p2g[3] = bfh(b4.y); p2g[4] = bfl(b4.z); p2g[5] = bfh(b4.z); p2g[6] = bfl(b4.w); p2g[7] = bfh(b4.w);
                p1v[0] = bfl(c.x); p1v[1] = bfh(c.x); p1v[2] = bfl(c.y); p1v[3] = bfh(c.y); p1v[4] = bfl(c.z); p1v[5] = bfh(c.z); p1v[6] = bfl(c.w); p1v[7] = bfh(c.w);
                p1g[0] = bfl(d4.x); p1g[1] = bfh(d4.x); p1g[2] = bfl(d4.y); p1g[3] = bfh(d4.y); p1g[4] = bfl(d4.z); p1g[5] = bfh(d4.z); p1g[6] = bfl(d4.w); p1g[7] = bfh(d4.w);
            }
            if (t0 == SEQ - 32) { outp = outCP + ((size_t)(l * 2 + b) * 2) * NUP + j0; out_t0 = 30; }
        } else {
            const int b = seg - 256; rowb = (size_t)MP + b * 4; ntok = 4;
            const float* sp = state_conv + ((size_t)(l * 32 + b) * 2) * NUP + j0;
#pragma unroll
            for (int e = 0; e < 8; ++e) { p2v[e] = sp[e]; p2g[e] = sp[DFF + e]; p1v[e] = sp[NUP + e]; p1g[e] = sp[NUP + DFF + e]; }
            outp = outCS + ((size_t)(l * 32 + b) * 2) * NUP + j0; out_t0 = 2;
        }
#pragma unroll 1
        for (int t0 = 0; t0 < ntok; t0 += 4) {
            v4u la[4], lb[4];
#pragma unroll
            for (int i = 0; i < 4; ++i) { la[i] = *(const v4u*)(U + (rowb + t0 + i) * NUP + j0); lb[i] = *(const v4u*)(U + (rowb + t0 + i) * NUP + DFF + j0); }
#pragma unroll
            for (int i = 0; i < 4; ++i) {
                const int t = t0 + i; const v4u a = la[i], b4 = lb[i];
                const float cv[8] = {bfl(a.x), bfh(a.x), bfl(a.y), bfh(a.y), bfl(a.z), bfh(a.z), bfl(a.w), bfh(a.w)};
                const float cg2[8] = {bfl(b4.x), bfh(b4.x), bfl(b4.y), bfh(b4.y), bfl(b4.z), bfh(b4.z), bfl(b4.w), bfh(b4.w)};
                float act[8];
#pragma unroll
                for (int e = 0; e < 8; ++e) {
                    const float vc = wv[0][e] * p2v[e] + wv[1][e] * p1v[e] + wv[2][e] * cv[e] + bv[e];
                    const float gc = wgt[0][e] * p2g[e] + wgt[1][e] * p1g[e] + wgt[2][e] * cg2[e] + bgt[e];
                    act[e] = gelu_tanh(gc) * vc;
                    p2v[e] = p1v[e]; p1v[e] = cv[e]; p2g[e] = p1g[e]; p1g[e] = cg2[e];
                }
                v4u w; w.x = pk2(act[0], act[1]); w.y = pk2(act[2], act[3]); w.z = pk2(act[4], act[5]); w.w = pk2(act[6], act[7]);
                *(v4u*)(ACT + (rowb + t) * DFF + j0) = w;
                if (outp && t >= out_t0) { float* op = outp + (size_t)(t - out_t0) * NUP;
                    *(f32x4*)op = (f32x4){cv[0], cv[1], cv[2], cv[3]}; *(f32x4*)(op + 4) = (f32x4){cv[4], cv[5], cv[6], cv[7]};
                    *(f32x4*)(op + DFF) = (f32x4){cg2[0], cg2[1], cg2[2], cg2[3]}; *(f32x4*)(op + DFF + 4) = (f32x4){cg2[4], cg2[5], cg2[6], cg2[7]}; }
            }
        }
    }
}
__device__ __forceinline__ void phase_convfix(int l, const float* RAWB, const float* w_conv, const float* b_conv, bf16* ACT, float* outCP) {
    for (int grp = lbid() + (int)gridDim.x * (ltid() >> 4); grp < 32 * 44 && ltid() < 96; grp += (int)gridDim.x * 6) {
        const int idx = grp * 16 + (ltid() & 15);
        const int cg = idx & 15, pn = (idx >> 4) % 44, pm = idx / (16 * 44), c0 = 8 * cg, j0 = 128 * pn + c0;
        const float* rb = RAWB + ((size_t)(pm * 44 + pn) * 4) * 256;
        float r0v[8], r1v[8], r0g[8], r1g[8], p2v[8], p1v[8], p2g[8], p1g[8];
#pragma unroll
        for (int e = 0; e < 8; ++e) { r0v[e] = rb[c0 + e]; r0g[e] = rb[128 + c0 + e]; r1v[e] = rb[256 + c0 + e]; r1g[e] = rb[256 + 128 + c0 + e]; }
        if ((pm & 15) == 0) {
#pragma unroll
            for (int e = 0; e < 8; ++e) { p2v[e] = 0.f; p1v[e] = 0.f; p2g[e] = 0.f; p1g[e] = 0.f; }
        } else { const float* pb = RAWB + ((size_t)((pm - 1) * 44 + pn) * 4 + 2) * 256;
#pragma unroll
            for (int e = 0; e < 8; ++e) { p2v[e] = pb[c0 + e]; p2g[e] = pb[128 + c0 + e]; p1v[e] = pb[256 + c0 + e]; p1g[e] = pb[256 + 128 + c0 + e]; }
        }
        float a0[8], a1[8];
#pragma unroll
        for (int e = 0; e < 8; ++e) {
            const float w0v = w_conv[((size_t)l * 3 + 0) * NUP + j0 + e], w1v = w_conv[((size_t)l * 3 + 1) * NUP + j0 + e], w2v = w_conv[((size_t)l * 3 + 2) * NUP + j0 + e], bv = b_conv[(size_t)l * NUP + j0 + e];
            const float w0g = w_conv[((size_t)l * 3 + 0) * NUP + DFF + j0 + e], w1g = w_conv[((size_t)l * 3 + 1) * NUP + DFF + j0 + e], w2g = w_conv[((size_t)l * 3 + 2) * NUP + DFF + j0 + e], bg = b_conv[(size_t)l * NUP + DFF + j0 + e];
            a0[e] = gelu_tanh(w0g * p2g[e] + w1g * p1g[e] + w2g * r0g[e] + bg) * (w0v * p2v[e] + w1v * p1v[e] + w2v * r0v[e] + bv);
            a1[e] = gelu_tanh(w0g * p1g[e] + w1g * r0g[e] + w2g * r1g[e] + bg) * (w0v * p1v[e] + w1v * r0v[e] + w2v * r1v[e] + bv);
        }
        v4u w; w.x = pk2(a0[0], a0[1]); w.y = pk2(a0[2], a0[3]); w.z = pk2(a0[4], a0[5]); w.w = pk2(a0[6], a0[7]);
        *(v4u*)(ACT + (size_t)(256 * pm) * DFF + j0) = w;
        w.x = pk2(a1[0], a1[1]); w.y = pk2(a1[2], a1[3]); w.z = pk2(a1[4], a1[5]); w.w = pk2(a1[6], a1[7]);
        *(v4u*)(ACT + (size_t)(256 * pm + 1) * DFF + j0) = w;
        if ((pm & 15) == 15) { const int b = pm >> 4; float* op = outCP + ((size_t)(l * 2 + b) * 2) * NUP + j0;
#pragma unroll
            for (int e = 0; e < 8; ++e) { op[e] = rb[2 * 256 + c0 + e]; op[DFF + e] = rb[2 * 256 + 128 + c0 + e]; op[NUP + e] = rb[3 * 256 + c0 + e]; op[NUP + DFF + e] = rb[3 * 256 + 128 + c0 + e]; } }
    }
}
constexpr int SK_PITCH = 528, SK_BUF = 64 * SK_PITCH;
#define SK_LOAD(s_) do { _Pragma("unroll") for (int j = 0; j < 4; ++j) st[j] = *(const v4u*)(A + (size_t)(rb + 8 * j + (gl >> 5)) * lda + kh * KH + (s_) * 256 + 8 * (gl & 31)); \
                         _Pragma("unroll") for (int j = 0; j < 4; ++j) st[4 + j] = *(const v4u*)(Wt + (size_t)(cb + 8 * j + (gl >> 5)) * ldb + kh * KH + (s_) * 256 + 8 * (gl & 31)); } while (0)
#define SK_STORE(b_) do { _Pragma("unroll") for (int j = 0; j < 8; ++j) *(LAS v4u*)(lds + ((b_) * 2 + kh) * SK_BUF + (8 * j + (gl >> 5)) * SK_PITCH + (gl & 31) * 16) = st[j]; } while (0)
__device__ __forceinline__ f32x4 skinny_acc(LAS unsigned char* lds, const bf16* A, int lda, const bf16* Wt, int ldb, int K, int rb, int cb, f32x4 acc) {
    const int tid = ltid(), lane = tid & 63, wave = tid >> 6, lr = lane & 15, g = lane >> 4, mt = wave & 1, nt = (wave >> 1) & 1, kh = wave >> 2, gl = tid & 255;
    const int KH = K >> 1, ns = KH >> 8;
    v4u st[8];
    SK_LOAD(0); SK_STORE(0);
    __syncthreads();
#pragma unroll 1
    for (int s2 = 0; s2 < ns; ++s2) {
        const bool more = s2 + 1 < ns;
        if (more) SK_LOAD(s2 + 1);
        const LAS unsigned char* ab = lds + ((s2 & 1) * 2 + kh) * SK_BUF + (16 * mt + lr) * SK_PITCH + g * 16;
        const LAS unsigned char* bb = lds + ((s2 & 1) * 2 + kh) * SK_BUF + (32 + 16 * nt + lr) * SK_PITCH + g * 16;
#pragma unroll
        for (int i = 0; i < 8; ++i) acc = __builtin_amdgcn_mfma_f32_16x16x32_bf16(as_frag(*(const LAS v4u*)(ab + 64 * i)), as_frag(*(const LAS v4u*)(bb + 64 * i)), acc, 0, 0, 0);
        if (more) SK_STORE((s2 + 1) & 1);
        __syncthreads();
    }
    return acc;
}
#undef SK_LOAD
#undef SK_STORE
__device__ __forceinline__ f32x4 skinny_reduce(LAS unsigned char* lds, f32x4 a, int kh, int ti, int lane) {
    LAS f32x4* R = (LAS f32x4*)lds;
    if (kh == 1) R[ti * 64 + lane] = a;
    __syncthreads();
    if (kh == 0) a = a + R[ti * 64 + lane];
    __syncthreads();
    return a;
}
__device__ __forceinline__ void skinny_mix(LAS unsigned char* lds, int item, const bf16* OA, const bf16* WOA, const bf16* OB, const bf16* WOB, const bf16* PROJ, bf16* MIX) {
    const int tid = ltid(), lane = tid & 63, wave = tid >> 6, lr = lane & 15, g = lane >> 4, mt = wave & 1, nt = (wave >> 1) & 1, kh = wave >> 2, rb = 32 * (item & 3), cb = 32 * (item >> 2);
    f32x4 a1 = {0.f, 0.f, 0.f, 0.f}, a2 = {0.f, 0.f, 0.f, 0.f};
    a1 = skinny_acc(lds, OA + (size_t)MP * 2048, 2048, WOA, 2048, 1024, rb, cb, a1);
    a2 = skinny_acc(lds, OB + (size_t)MP * 2048, 2048, WOB, 2048, 1024, rb, cb, a2);
    a1 = skinny_reduce(lds, a1, kh, wave & 3, lane); a2 = skinny_reduce(lds, a2, kh, wave & 3, lane);
    if (kh == 0) { const int colb = cb + 16 * nt + lr;
#pragma unroll
        for (int r = 0; r < 4; ++r) { const size_t row = (size_t)MP + rb + 16 * mt + 4 * g + r;
            const float ga = bf1(PROJ[row * NIN + C_GA + colb]), gb = bf1(PROJ[row * NIN + C_GB + colb]);
            MIX[row * D + colb] = f2bf(sigm(ga) * a1[r] + sigm(gb) * a2[r]); }
    }
}
__device__ __forceinline__ void skinny_res(LAS unsigned char* lds, int item, const bf16* A, const bf16* Wt, int K, bf16* XB, float* Yf, float* SS) {
    const int tid = ltid(), lane = tid & 63, wave = tid >> 6, lr = lane & 15, g = lane >> 4, mt = wave & 1, nt = (wave >> 1) & 1, kh = wave >> 2, rb = 32 * (item & 3), cb = 32 * (item >> 2);
    f32x4 a1 = {0.f, 0.f, 0.f, 0.f};
    a1 = skinny_acc(lds, A + (size_t)MP * K, K, Wt, K, K, rb, cb, a1);
    a1 = skinny_reduce(lds, a1, kh, wave & 3, lane);
    if (kh == 0) { const int colb = cb + 16 * nt + lr;
#pragma unroll
        for (int r = 0; r < 4; ++r) { const size_t row = (size_t)MP + rb + 16 * mt + 4 * g + r, o = row * D + colb; const float y = bf1(XB[o]) + a1[r];
            if (Yf) Yf[o] = y;
            else { const bf16 yb = f2bf(y); XB[o] = yb; const float yr = bf1(yb); float ss = red16_sum(yr * yr);
                if (lr == 0) SS[(size_t)MP * 32 + (row - MP) * 128 + (cb >> 4) + nt] = ss; } }
    }
}
__device__ __forceinline__ void phase_rstd(const float* SS, float* RS) {
    for (int row = lbid() * 512 + ltid(); row < MREAL; row += gridDim.x * 512) {
        f32x4 t = {0.f, 0.f, 0.f, 0.f};
        if (row < MP) { const f32x4* sp = (const f32x4*)(SS + (size_t)row * 32);
#pragma unroll
            for (int i = 0; i < 8; ++i) t += sp[i]; }
        else { const f32x4* sp = (const f32x4*)(SS + (size_t)MP * 32 + (size_t)(row - MP) * 128);
#pragma unroll 8
            for (int i = 0; i < 32; ++i) t += sp[i]; }
        RS[row] = rsqrtf(((t[0] + t[1]) + (t[2] + t[3])) * (1.0f / D) + EPS);
    }
}
struct Args { const float* in[23]; float* out; unsigned char* ws; int l_lo, l_hi, ph_lo, ph_hi; };
typedef const __attribute__((address_space(4))) Args* ArgsP;
__device__ __forceinline__ ArgsP largs() { ArgsP p = (ArgsP)__builtin_amdgcn_kernarg_segment_ptr(); asm volatile("" : "+s"(p)); return p; }
enum { I_XP = 0, I_XS, I_CK, I_CV, I_SG, I_SC, I_RB, I_LN1, I_WIN, I_LNQ, I_LNK, I_SINK, I_WGK2, I_BGK, I_LNO, I_WOA, I_WOB, I_WOUT, I_LN2, I_WUP, I_WCONV, I_BCONV, I_WDN };
__global__ void __launch_bounds__(512, 2) hyb_fwd(Args a) {
    extern __shared__ __attribute__((aligned(16))) unsigned char lds_raw[];
    LAS unsigned char* lds = (LAS unsigned char*)lds_raw;
    volatile LAS unsigned* MISC = (volatile LAS unsigned*)(lds + MISC_OFF);
    if (threadIdx.x < 32) MISC[threadIdx.x] = 0u;
    __syncthreads();
    const bool fused = (a.ph_hi - a.ph_lo > 1) || (a.l_hi - a.l_lo > 1);
    XcdBarrier bar; bar.bar = (unsigned*)(a.ws + WS_CTL) + CW_BAR; bar.x = 0; bar.st = MISC + 8;
    if (fused) bar = xcd_barrier_post((unsigned*)(a.ws + WS_CTL) + CW_BAR, MISC + 8);
#ifndef PHMASK
#define PHMASK 0x7ff
#endif
#define IN(k) (((PHMASK >> (k)) & 1) && a.ph_lo <= (k) && (k) < a.ph_hi)
#ifndef REPMASK
#define REPMASK 0
#endif
#define REP(k) (((REPMASK >> (k)) & 1) ? 2 : 1)
#define SEAM(k) do { if (fused && !((k) == NPH - 1 && l == a.l_hi - 1)) xcd_barrier(bar); } while (0)
#define WSP(off, T) ((T*)(A->ws + (off)))
#define WSW(off) ((bf16*)(A->ws + (off) + ((l & 1) ? (WS_W2 - WS_WIN) : (size_t)0)))
#pragma unroll 1
    for (int l = a.l_lo; l < a.l_hi; ++l) {
        if (IN(0) && l == 0) for (int rep_ = 0; rep_ < REP(0); ++rep_) {
            ArgsP A = largs();
            { const int G = gridDim.x; const CvPlan cp = cvt_plan(G);
              cvt_range(lds, 0, min(cp.X, DEPTH * CV_NIT), lbid() * 8 + (ltid() >> 6), G * 8, A->in[I_WIN], A->in[I_WOA], A->in[I_WOB], A->in[I_WOUT], A->in[I_WUP], A->in[I_WDN], A->ws, A->in[I_LN1], A->in[I_LN2]); }
            if (l == 0) phase_bias(A->in[I_RB], WSP(WS_BIAS, float));
            if (l == 0) phase_first(A->in[I_XP], A->in[I_XS], WSP(WS_H, bf16), WSP(WS_SS2, float));
            SEAM(0);
        }
        if (IN(1)) for (int rep_ = 0; rep_ < REP(1); ++rep_) {
            ArgsP A = largs();
            pg8::Gemm g{WSP(WS_H, bf16), WSW(WS_WIN), MPAD, NIN, D}; pg8::StaticOrder S; S.init(MPAD, NIN, gridDim.x, lbid());
            pg8::EpiBf E{WSP(WS_GT, pg8::u32x4), C_GA / 256, WSP(WS_PROJ, bf16), NIN, WSP(WS_GK, float), C_GK / 256, WSP(WS_SS2, float), (PG8_LAS float*)(lds + RING_BYTES) + 3072};
            pg8::gemm_phase<pg8::EpiBf, pg8::StaticOrder, true, true>(lds, g, S, E);
            { const int G = gridDim.x, u1 = (MPAD / 256) * (NIN / 256), first = u1 % G, idle1 = first ? G - first : 0; const CvPlan cp = cvt_plan(G);
              if (idle1 && lbid() >= first) cvt_range(lds, min(l * CV_NIT + cp.X, DEPTH * CV_NIT), min(l * CV_NIT + cp.X + cp.T1, DEPTH * CV_NIT), (lbid() - first) * 8 + (ltid() >> 6), idle1 * 8,
                                                                       A->in[I_WIN], A->in[I_WOA], A->in[I_WOB], A->in[I_WOUT], A->in[I_WUP], A->in[I_WDN], A->ws, A->in[I_LN1], A->in[I_LN2]); }
            SEAM(1);
        }
        if (IN(2)) for (int rep_ = 0; rep_ < REP(2); ++rep_) {
            { ArgsP A = largs(); const int G = gridDim.x;
              for (int u = lbid(); u < 256; u += G) attn_prompt_unit(lds, u, l, WSP(WS_PROJ, bf16), A->in[I_LNQ], A->in[I_LNK], A->in[I_SINK], WSP(WS_BIAS, float), WSP(WS_OA, bf16), A->out + O_KP, A->out + O_VP); }
            { ArgsP A = largs(); const int G = gridDim.x;
              for (int u = lbid(); u < 256; u += G) { const int c = u & 31, h = (u >> 5) & 3, b = u >> 7;
                gla_a_unit(lds, l, h, (size_t)b * SEQ + c * GC, WSP(WS_PROJ, bf16), WSP(WS_GK, float), A->in[I_WGK2], A->in[I_BGK], WSP(WS_QT, bf16), WSP(WS_KT, bf16),
                           WSP(WS_GU, float) + ((size_t)((b * 4 + h) * NCH + c)) * 32768, WSP(WS_GDL, float) + ((b * 4 + h) * NCH + c) * 128); } }
            SEAM(2);
        }
        if (IN(3)) for (int rep_ = 0; rep_ < REP(3); ++rep_) {
            { ArgsP A = largs(); gla_scan2(l, WSP(WS_GU, float), WSP(WS_GDL, float), WSP(WS_GS, bf16), A->out + O_GP); }
            { ArgsP A = largs(); const int G = gridDim.x, GH = G >> 1;
              for (int u = lbid(); u < 128 && lbid() < GH; u += GH) { const int h = u & 3, b = u >> 2;
                gla_unit<true>(lds, l, h, (size_t)MP + b * 4, 4, WSP(WS_PROJ, bf16), WSP(WS_GK, float), A->in[I_WGK2], A->in[I_BGK], A->in[I_LNO], A->in[I_SG] + ((size_t)((l * 32 + b) * 4 + h)) * 32768,
                               A->out + O_GS + ((size_t)((l * 32 + b) * 4 + h)) * 32768, nullptr, WSP(WS_OB, bf16)); } }
            { ArgsP A = largs(); const int G = gridDim.x, GH = G >> 1;
              for (int u = lbid() - GH; u >= 0 && u < 128; u += G - GH) attn_sample_unit(lds, u, l, WSP(WS_PROJ, bf16), A->in[I_CK], A->in[I_CV], A->in[I_LNQ], A->in[I_LNK], A->in[I_SINK], WSP(WS_BIAS, float), WSP(WS_OA, bf16), A->out + O_KS, A->out + O_VS); }
            SEAM(3);
        }
        if (IN(4)) for (int rep_ = 0; rep_ < REP(4); ++rep_) {
            ArgsP A = largs(); const int G = gridDim.x;
            for (int u = lbid(); u < 256; u += G) { const int c = u & 31, h = (u >> 5) & 3, b = u >> 7;
                gla_c_unit(lds, l, h, (size_t)b * SEQ + c * GC, WSP(WS_PROJ, bf16), WSP(WS_QT, bf16), WSP(WS_KT, bf16), WSP(WS_GS, bf16) + ((size_t)((b * 4 + h) * NCH + c)) * 32768, A->in[I_LNO], WSP(WS_OB, bf16)); }
            SEAM(4);
        }
        if (IN(5)) for (int rep_ = 0; rep_ < REP(5); ++rep_) {
            { ArgsP A = largs(); pg8::StaticOrder S; S.init(MP, D, gridDim.x, lbid());
              pg8::Gemm g{WSP(WS_OA, bf16), WSW(WS_WOA), MP, D, 2048}; pg8::EpiMix E{WSP(WS_GT, pg8::u32x4), WSP(WS_MIX, bf16)}; pg8::gemm_phase<pg8::EpiMix, pg8::StaticOrder, true, true>(lds, g, S, E); }
            { ArgsP A = largs(); const int G = gridDim.x;
              for (int it = lbid(); it < 256; it += G) skinny_mix(lds, it, WSP(WS_OA, bf16), WSW(WS_WOA), WSP(WS_OB, bf16), WSW(WS_WOB), WSP(WS_PROJ, bf16), WSP(WS_MIX, bf16)); }
            SEAM(5);
        }
        if (IN(6)) for (int rep_ = 0; rep_ < REP(6); ++rep_) {
            ArgsP A = largs();
            pg8::Gemm g{WSP(WS_MIX, bf16), WSW(WS_WOUT), MP, D, D}; pg8::StaticOrder S; S.init(MP, D, gridDim.x, lbid());
            pg8::EpiRes E{WSP(WS_H, bf16), nullptr, WSP(WS_SS1, float)};
            pg8::gemm_phase<pg8::EpiRes, pg8::StaticOrder, true, true>(lds, g, S, E);
            { const int G = gridDim.x; for (int it = lbid(); it < 256; it += G) skinny_res(lds, it, WSP(WS_MIX, bf16), WSW(WS_WOUT), D, WSP(WS_H, bf16), nullptr, WSP(WS_SS1, float)); }
            SEAM(6);
        }
        if (IN(8)) for (int rep_ = 0; rep_ < REP(8); ++rep_) {
            ArgsP A = largs();
            pg8::Gemm g{WSP(WS_H, bf16), WSW(WS_WUP), MPAD, NUP, D}; pg8::StaticOrder S; S.init(MPAD, NUP, gridDim.x, lbid());
            pg8::EpiUp E{WSP(WS_ACT, bf16), WSP(WS_U, bf16), WSP(WS_RAWB, float), WSP(WS_SS1, float), A->in[I_WCONV] + (size_t)l * 3 * NUP, A->in[I_BCONV] + (size_t)l * NUP, (PG8_LAS float*)(lds + RING_BYTES)};
            pg8::gemm_phase<pg8::EpiUp, pg8::StaticOrder, true, true>(lds, g, S, E);
            { const int G = gridDim.x, u2 = (MPAD / 256) * (NUP / 256), first = u2 % G, idle2 = first ? G - first : 0; const CvPlan cp = cvt_plan(G);
              if (idle2 && lbid() >= first) cvt_range(lds, min(l * CV_NIT + cp.X + cp.T1, DEPTH * CV_NIT), min(l * CV_NIT + cp.X + cp.T1 + cp.T2, DEPTH * CV_NIT), (lbid() - first) * 8 + (ltid() >> 6), idle2 * 8,
                                                                       A->in[I_WIN], A->in[I_WOA], A->in[I_WOB], A->in[I_WOUT], A->in[I_WUP], A->in[I_WDN], A->ws, A->in[I_LN1], A->in[I_LN2]); }
            SEAM(8);
        }
        if (IN(9)) for (int rep_ = 0; rep_ < REP(9); ++rep_) { ArgsP A = largs(); phase_convfix(l, WSP(WS_RAWB, float), A->in[I_WCONV], A->in[I_BCONV], WSP(WS_ACT, bf16), A->out + O_CP);
            phase_conv(l, WSP(WS_U, bf16), A->in[I_SC], A->in[I_WCONV], A->in[I_BCONV], WSP(WS_ACT, bf16), A->out + O_CP, A->out + O_CS, 256, 32);
            { const int G = gridDim.x; const CvPlan cp = cvt_plan(G);
              cvt_range(lds, min(l * CV_NIT + cp.X + cp.T1 + cp.T2, DEPTH * CV_NIT), min((l + 1) * CV_NIT + cp.X, DEPTH * CV_NIT), lbid() * 8 + (ltid() >> 6), G * 8,
                        A->in[I_WIN], A->in[I_WOA], A->in[I_WOB], A->in[I_WOUT], A->in[I_WUP], A->in[I_WDN], A->ws, A->in[I_LN1], A->in[I_LN2]); }
            SEAM(9); }
        if (IN(10)) for (int rep_ = 0; rep_ < REP(10); ++rep_) {
            ArgsP A = largs();
            pg8::Gemm g{WSP(WS_ACT, bf16), WSW(WS_WDN), MP, D, DFF}; pg8::StaticOrder S; S.init(MP, D, gridDim.x, lbid());
            const bool lastl = (l == DEPTH - 1);
            pg8::EpiRes E{WSP(WS_H, bf16), lastl ? A->out + O_Y : nullptr, WSP(WS_SS2, float)};
            pg8::gemm_phase<pg8::EpiRes, pg8::StaticOrder, true, true>(lds, g, S, E);
            { const int G = gridDim.x; for (int it = lbid(); it < 256; it += G) skinny_res(lds, it, WSP(WS_ACT, bf16), WSW(WS_WDN), DFF, WSP(WS_H, bf16), lastl ? A->out + O_Y : nullptr, WSP(WS_SS2, float)); }
            SEAM(10);
        }
    }
#undef IN
#undef SEAM
#undef WSP
}

#ifndef HYB_FUSED
#define HYB_FUSED 1
#endif
extern "C" void kernel_launch(void* const* d_in, const int* in_sizes, int n_in, void* d_out, int out_size, void* d_ws, size_t ws_size, hipStream_t stream) {
    static int grid = 0;
    if (grid == 0) {
        if (n_in != 23 || (size_t)out_size != O_END || ws_size < WS_END) { fprintf(stderr, "kernel_launch: unexpected shapes: n_in %d out %d ws %zu (need %zu)\n", n_in, out_size, ws_size, (size_t)WS_END); grid = -1; return; }
        int dev = 0, cus = 0, per_cu = 0;
        if (hipGetDevice(&dev) != hipSuccess || hipDeviceGetAttribute(&cus, hipDeviceAttributeMultiprocessorCount, dev) != hipSuccess) { grid = -1; return; }
        if (hipFuncSetAttribute((const void*)hyb_fwd, hipFuncAttributeMaxDynamicSharedMemorySize, LDS_BYTES) != hipSuccess) { fprintf(stderr, "kernel_launch: hipFuncSetAttribute failed\n"); grid = -1; return; }
        if (hipOccupancyMaxActiveBlocksPerMultiprocessor(&per_cu, (const void*)hyb_fwd, 512, LDS_BYTES) != hipSuccess || per_cu < 1) fprintf(stderr, "kernel_launch: occupancy query says %d\n", per_cu);
        (void)hipGetLastError();
        grid = cus;
    }
    if (grid < 0) return;
    (void)hipMemsetAsync((char*)d_ws + WS_CTL, 0, CTL_BYTES, stream);
    Args a{};
    for (int i = 0; i < 23; ++i) a.in[i] = (const float*)d_in[i];
    a.out = (float*)d_out; a.ws = (unsigned char*)d_ws;
#if HYB_FUSED
    a.l_lo = 0; a.l_hi = DEPTH; a.ph_lo = 0; a.ph_hi = NPH;
    hipLaunchKernelGGL(hyb_fwd, dim3(grid), dim3(512), LDS_BYTES, stream, a);
#else
    for (int l = 0; l < DEPTH; ++l)
        for (int p = 0; p < NPH; ++p) { a.l_lo = l; a.l_hi = l + 1; a.ph_lo = p; a.ph_hi = p + 1; hipLaunchKernelGGL(hyb_fwd, dim3(grid), dim3(512), LDS_BYTES, stream, a); }
#endif
}
```
